# Optimizing an MI355X kernel written in HIP

```python
import jax, jax.numpy as jnp
from jax import lax
import numpy as np

D_MODEL = 1024
BATCH = 2
SEQ = 8192
DEPTH = 4

N_MIXERS = 3
EPS = 1e-6
CHUNK = 128
A_WIDTH = 2 * D_MODEL
A_GROUPS = 8
A_GROUP_DIM = A_WIDTH // A_GROUPS
HEAD_DIM = 128
B_HEADS = D_MODEL // HEAD_DIM
B_PATTERNS = ((128, 1), (512, 4), (2048, 16))
N_B_GROUPS = len(B_PATTERNS)
B_WIDTH = B_HEADS * HEAD_DIM
B_IN_WIDTH = 3 * N_B_GROUPS * B_WIDTH + B_WIDTH
ROPE_DIM = HEAD_DIM // 4
ROPE_THETA = 500000.0
POOL_SIZES = (2, 4, 8, 16)
N_POOL = len(POOL_SIZES)
C_WIDTH = 2 * D_MODEL
C_GROUP = C_WIDTH // N_POOL
N_A = (DEPTH + 2) // 3
N_B = (DEPTH + 1) // 3
N_C = DEPTH // 3

kernel_name = "hybrid_gmlp_dilated_attn_pool_interleaved"


def rms_norm(x, g):
    xf = x.astype(jnp.float32)
    y = xf * lax.rsqrt(jnp.mean(xf * xf, axis=-1, keepdims=True) + EPS)
    return (y * g.astype(jnp.float32)).astype(x.dtype)


def rotary_tables(seq_len):
    half = ROPE_DIM // 2
    inv_freq = jnp.power(jnp.float32(ROPE_THETA), -jnp.arange(half, dtype=jnp.float32) / half)
    ang = jnp.arange(seq_len, dtype=jnp.float32)[:, None] * inv_freq[None, :]
    return jnp.cos(ang)[None, :, None, :], jnp.sin(ang)[None, :, None, :]


def apply_partial_rotary(x, cos, sin):
    half = ROPE_DIM // 2
    x1 = x[..., :half].astype(jnp.float32)
    x2 = x[..., half:ROPE_DIM].astype(jnp.float32)
    rot = jnp.concatenate([x1 * cos - x2 * sin, x2 * cos + x1 * sin], axis=-1)
    return jnp.concatenate([rot.astype(x.dtype), x[..., ROPE_DIM:]], axis=-1)


def dilated_window_attention(q, k, v, span, dilation):
    bsz, S, H, hd = q.shape
    blk = span
    L = S // dilation
    nb = -(-L // blk)
    Lp = nb * blk

    def to_blocks(t):
        t = t.reshape(bsz, L, dilation, H, hd).transpose(0, 2, 1, 3, 4)
        t = jnp.pad(t, ((0, 0), (0, 0), (0, Lp - L), (0, 0), (0, 0)))
        return t.reshape(bsz, dilation, nb, blk, H, hd)

    def with_prev(t):
        prev = jnp.pad(t, ((0, 0), (0, 0), (1, 0), (0, 0), (0, 0), (0, 0)))[:, :, :-1]
        return jnp.concatenate([prev, t], axis=3)

    qb = to_blocks(q).astype(jnp.float32)
    kk = with_prev(to_blocks(k)).astype(jnp.float32)
    vv = with_prev(to_blocks(v)).astype(jnp.float32)
    scores = jnp.einsum('brnqhd,brnkhd->brnhqk', qb, kk) * (1.0 / np.sqrt(hd)).astype(np.float32)
    qi = jnp.arange(blk)[:, None]
    ki = jnp.arange(2 * blk)[None, :]
    dist = blk + qi - ki
    band = (dist >= 0) & (dist <= span)
    has_prev = (jnp.arange(nb) > 0)[:, None, None] | (ki >= blk)[None]
    mask = band[None] & has_prev
    scores = jnp.where(mask[None, None, :, None], scores, -jnp.inf)
    lse = jax.nn.logsumexp(scores, axis=-1)
    p = jnp.exp(scores - lse[..., None])
    o = jnp.einsum('brnhqk,brnkhd->brnqhd', p, vv)
    o = o.reshape(bsz, dilation, Lp, H, hd)[:, :, :L].transpose(0, 2, 1, 3, 4).reshape(bsz, S, H, hd)
    lse = lse.transpose(0, 1, 2, 4, 3).reshape(bsz, dilation, Lp, H)[:, :, :L]
    lse = lse.transpose(0, 2, 1, 3).reshape(bsz, S, H)
    return o, lse


def mixer_a(h, w_in, v_gain, w_s, b_s, w_out):
    bsz, S, _ = h.shape
    proj = h @ w_in
    u = proj[..., :A_WIDTH]
    v = rms_norm(proj[..., A_WIDTH:2 * A_WIDTH], v_gain)
    z = proj[..., 2 * A_WIDTH:]
    nc = S // CHUNK
    v = v.reshape(bsz, nc, CHUNK, A_GROUPS, A_GROUP_DIM)
    causal = jnp.tril(jnp.ones((CHUNK, CHUNK), dtype=bool))
    ws = jnp.where(causal[None], w_s, jnp.zeros_like(w_s))
    mixed = jnp.einsum('gij,bcjgd->bcigd', ws, v) + b_s.T[None, None, :, :, None]
    mixed = mixed.reshape(bsz, S, A_WIDTH)
    y = u * mixed * jax.nn.silu(z)
    return y @ w_out


def mixer_b(h, w_in, q_gain, k_gain, w_out):
    bsz, S, _ = h.shape
    proj = h @ w_in
    n_qkv = 3 * N_B_GROUPS * B_WIDTH
    qkv = proj[..., :n_qkv].reshape(bsz, S, 3, N_B_GROUPS, B_HEADS, HEAD_DIM)
    z = proj[..., n_qkv:]
    cos, sin = rotary_tables(S)
    outs, lses = [], []
    for g, (window, dilation) in enumerate(B_PATTERNS):
        q = apply_partial_rotary(rms_norm(qkv[:, :, 0, g], q_gain[g]), cos, sin)
        k = apply_partial_rotary(rms_norm(qkv[:, :, 1, g], k_gain[g]), cos, sin)
        o, lse = dilated_window_attention(q, k, qkv[:, :, 2, g], window // dilation, dilation)
        outs.append(o)
        lses.append(lse)
    wgt = jax.nn.softmax(jnp.stack(lses), axis=0)
    o = jnp.einsum('gbsh,gbshd->bshd', wgt, jnp.stack(outs))
    y = o.reshape(bsz, S, B_WIDTH).astype(h.dtype) * jax.nn.silu(z)
    return y @ w_out


def causal_mean(x, window):
    S = x.shape[1]
    c = jnp.cumsum(x.astype(jnp.float32), axis=1)
    c_prev = jnp.pad(c, ((0, 0), (window, 0), (0, 0)))[:, :S]
    cnt = jnp.minimum(jnp.arange(S) + 1, window).astype(jnp.float32)
    return ((c - c_prev) / cnt[None, :, None]).astype(x.dtype)


def mixer_c(h, w_in, w_grp, scale, w_out):
    bsz, S, _ = h.shape
    proj = h @ w_in
    xc = proj[..., :C_WIDTH].reshape(bsz, S, N_POOL, C_GROUP)
    z = proj[..., C_WIDTH:]
    pooled = jnp.stack([causal_mean(xc[:, :, g], w) for g, w in enumerate(POOL_SIZES)], axis=2)
    mixed = jnp.einsum('bsgc,gcd->bsgd', pooled - xc, w_grp).reshape(bsz, S, C_WIDTH) * scale
    y = mixed * jax.nn.silu(z)
    return y @ w_out


def setup_inputs(seed: int = 0) -> dict:
    key = jax.random.key(seed)
    ks = jax.random.split(key, 16)
    f32 = jnp.float32

    def nrm(k, shape, fan_in):
        return jax.random.normal(k, shape, f32) * (fan_in ** -0.5)

    def gain(k, shape):
        return 1.0 + 0.1 * jax.random.normal(k, shape, f32)

    return {
        "x": jax.random.normal(ks[0], (BATCH, SEQ, D_MODEL), f32),
        "norm_gain": gain(ks[1], (DEPTH, D_MODEL)),
        "a_w_in": nrm(ks[2], (N_A, D_MODEL, 3 * A_WIDTH), D_MODEL),
        "a_v_gain": gain(ks[3], (N_A, A_WIDTH)),
        "a_w_s": nrm(ks[4], (N_A, A_GROUPS, CHUNK, CHUNK), CHUNK),
        "a_b_s": gain(ks[5], (N_A, A_GROUPS, CHUNK)),
        "a_w_out": nrm(ks[6], (N_A, A_WIDTH, D_MODEL), A_WIDTH),
        "b_w_in": nrm(ks[7], (N_B, D_MODEL, B_IN_WIDTH), D_MODEL),
        "b_q_gain": gain(ks[8], (N_B, N_B_GROUPS, HEAD_DIM)),
        "b_k_gain": gain(ks[9], (N_B, N_B_GROUPS, HEAD_DIM)),
        "b_w_out": nrm(ks[10], (N_B, B_WIDTH, D_MODEL), B_WIDTH),
        "c_w_in": nrm(ks[11], (N_C, D_MODEL, 2 * C_WIDTH), D_MODEL),
        "c_w_grp": nrm(ks[12], (N_C, N_POOL, C_GROUP, C_GROUP), C_GROUP),
        "c_scale": gain(ks[13], (N_C, C_WIDTH)),
        "c_w_out": nrm(ks[14], (N_C, C_WIDTH, D_MODEL), C_WIDTH),
    }


def reference(x, norm_gain, a_w_in, a_v_gain, a_w_s, a_b_s, a_w_out,
              b_w_in, b_q_gain, b_k_gain, b_w_out,
              c_w_in, c_w_grp, c_scale, c_w_out):
    for i in range(DEPTH):
        kind, j = i % N_MIXERS, i // N_MIXERS
        h = rms_norm(x, norm_gain[i])
        if kind == 0:
            y = mixer_a(h, a_w_in[j], a_v_gain[j], a_w_s[j], a_b_s[j], a_w_out[j])
        elif kind == 1:
            y = mixer_b(h, b_w_in[j], b_q_gain[j], b_k_gain[j], b_w_out[j])
        else:
            y = mixer_c(h, c_w_in[j], c_w_grp[j], c_scale[j], c_w_out[j])
        x = x + y.astype(x.dtype)
    return x
```

```cpp
#include <hip/hip_runtime.h>
#include <cstdio>
#include <cstdint>

#define LAS __attribute__((address_space(3)))
#define GAS __attribute__((address_space(1)))
typedef unsigned short bf16;
typedef short bf16x8 __attribute__((ext_vector_type(8)));
typedef float f32x4 __attribute__((ext_vector_type(4)));
typedef float f32x16 __attribute__((ext_vector_type(16)));
typedef unsigned u32x4 __attribute__((ext_vector_type(4)));
typedef unsigned u32x2 __attribute__((ext_vector_type(2)));
typedef float f32x2_t __attribute__((ext_vector_type(2)));
typedef __bf16 bf16x2_t __attribute__((ext_vector_type(2)));
typedef int i32x4 __attribute__((ext_vector_type(4)));
typedef int i32x8 __attribute__((ext_vector_type(8)));

constexpr int D = 1024, BATCH = 2, SEQ = 8192, M = BATCH * SEQ;
constexpr float EPS = 1e-6f;
constexpr int AW = 2048, AIN = 3 * AW;
constexpr int BIN = 10240;
constexpr int CW = 2048, CIN = 2 * CW;

__device__ __forceinline__ unsigned cvtpk(float lo, float hi) { f32x2_t v = {lo, hi}; bf16x2_t b = __builtin_convertvector(v, bf16x2_t); return __builtin_bit_cast(unsigned, b); }
__device__ __forceinline__ unsigned pk8(float a, float b, float c, float d) { int w = __builtin_amdgcn_cvt_pk_fp8_f32(a, b, 0, false); w = __builtin_amdgcn_cvt_pk_fp8_f32(c, d, w, true); return (unsigned)w; }
__device__ __forceinline__ float bf_lo(unsigned w) { return __uint_as_float(w << 16); }
__device__ __forceinline__ float bf_hi(unsigned w) { return __uint_as_float(w & 0xffff0000u); }
__device__ __forceinline__ float silu_f(float z) { return z * __builtin_amdgcn_rcpf(1.f + __builtin_amdgcn_exp2f(-1.4426950408889634f * z)); }
__device__ __forceinline__ float sum_x32(float v) { const auto r = __builtin_amdgcn_permlane32_swap(__float_as_uint(v), __float_as_uint(v), false, false); return __uint_as_float(r[0]) + __uint_as_float(r[1]); }
__device__ __forceinline__ float sum_x16(float v) { const auto r = __builtin_amdgcn_permlane16_swap(__float_as_uint(v), __float_as_uint(v), false, false); return __uint_as_float(r[0]) + __uint_as_float(r[1]); }
__device__ __forceinline__ float get_x32(float v, bool lower_half) { const auto r = __builtin_amdgcn_permlane32_swap(__float_as_uint(v), __float_as_uint(v), false, false); return __uint_as_float(lower_half ? r[1] : r[0]); }
template <int CTRL> __device__ __forceinline__ float dpp_f(float v) { return __int_as_float(__builtin_amdgcn_update_dpp(0, __float_as_int(v), CTRL, 0xf, 0xf, true)); }
template <int S> __device__ __forceinline__ float dpp_ror(float v) { return __int_as_float(__builtin_amdgcn_update_dpp(0, __float_as_int(v), 0x120 + S, 0xf, 0xf, true)); }
template <int S> __device__ __forceinline__ float dpp_shr_old(float old, float v) { return __int_as_float(__builtin_amdgcn_update_dpp(__float_as_int(old), __float_as_int(v), 0x110 + S, 0xf, 0xf, false)); }
__device__ __forceinline__ float row16_sum(float v) { v += dpp_f<0x128>(v); v += dpp_f<0x124>(v); v += dpp_f<0x122>(v); v += dpp_f<0x121>(v); return v; }
__device__ __forceinline__ int lane_id() { int l; asm volatile("v_mbcnt_lo_u32_b32 %0, -1, 0\n\tv_mbcnt_hi_u32_b32 %0, -1, %0" : "=v"(l)); return l; }
__device__ __forceinline__ float max_x32(float v) { const auto r = __builtin_amdgcn_permlane32_swap(__float_as_uint(v), __float_as_uint(v), false, false); return fmaxf(__uint_as_float(r[0]), __uint_as_float(r[1])); }
__device__ __forceinline__ float wave_sum(float v) { return sum_x32(sum_x16(row16_sum(v))); }
#define LDS_WAIT() asm volatile("s_waitcnt lgkmcnt(0)" ::: "memory")
#define VM_WAIT() asm volatile("s_waitcnt vmcnt(0)" ::: "memory")

namespace pg8 {
constexpr int BM = 256, BK = 64, HALF = 128, HTB = HALF * BK * 2  , STAGE_BYTES = 8 * HTB, NXCD = 8, WGM = 4;
__host__ __device__ __forceinline__ int lds_byte(int r, int c) { const int st = (r >> 4) * 2 + (c >> 5), rr = r & 15, cc = c & 31, ob = rr * 64 + cc * 2; return st * 1024 + (ob ^ (((ob >> 9) & 1) << 5)); }
__host__ __device__ __forceinline__ void stage_rc(int b, int& R, int& C) { const int st = b / 1024, sb = b % 1024, swz = sb ^ (((sb >> 9) & 1) << 5); R = (st >> 1) * 16 + swz / 64; C = (st & 1) * 32 + (swz % 64) / 2; }
__host__ __device__ __forceinline__ int perm32(int rho) { const int n = rho >> 4, i = rho & 15; return 8 * (i >> 2) + 4 * n + (i & 3); }

struct Unit { int pm, pn, kind; unsigned rsa, rsb, a, b, bswz; };

struct TileOrder {
    int nM, nN, nwg, G, c;
    __device__ void init(int nM_, int nN_, int G_, int c_) { nM = nM_; nN = nN_; nwg = nM * nN; G = G_; c = c_; }
    __device__ bool tile(int i, int& pm, int& pn) const {
        const long L = (long)i * G + c; if (L >= nwg) return false;
        int wgid = (int)L; { const int q = nwg / NXCD, r = nwg % NXCD, xcd = wgid % NXCD, off = wgid / NXCD; wgid = (xcd < r ? xcd * (q + 1) : r * (q + 1) + (xcd - r) * q) + off; }
        const int nig = WGM * nN, gid = wgid / nig, fm = gid * WGM, gsz = (nM - fm) < WGM ? (nM - fm) : WGM;
        pm = fm + ((wgid % nig) % gsz); pn = (wgid % nig) / gsz; return true;
    }
};

template <class Epi, class Sched, bool ALIGN_EPI, bool F8 = false>
__device__ __forceinline__ void gemm_phase(LAS unsigned char* lds, const unsigned char* wsb, const int K, const Sched& S, const Epi& E, const int wave) {
    int wid = wave; asm volatile("" : "+s"(wid));
    const int tid = wid * 64 + lane_id();
    const int lane = tid & 63, wr = wid >> 2, wc = wid & 3, fr = lane & 15, fq = lane >> 4;
    const int nt = K / BK;
#define PG8_VOFF(vA, vB, rsa_, rsb_, bswz_) do { const int tid_ = wid * 64 + lane_id(); _Pragma("unroll") for (int _i = 0; _i < 2; ++_i) { int R_, C_; stage_rc(tid_ * 16 + _i * 8192, R_, C_); \
        int Rb_ = Epi::PERM ? ((R_ & ~31) + perm32(R_ & 31)) : R_; if (bswz_) Rb_ ^= (((Rb_ >> 2) ^ (Rb_ >> 3)) & 1) * 12; vA[_i] = (unsigned)R_ * (rsa_) + (unsigned)C_ * 2u; vB[_i] = (unsigned)Rb_ * (rsb_) + (unsigned)C_ * 2u; } } while (0)
    const unsigned kstep = (unsigned)(BK * 2);
    const unsigned ldsw = (unsigned)wid * 1024u;
    const int aoff = lds_byte(wr * 64 + fr, fq * 8), boff = lds_byte(wc * 32 + fr, fq * 8);
#define PG8_SA(b, h) (((b) * 2 + (h)) * HTB)
#define PG8_SB(b, h) ((4 + (b) * 2 + (h)) * HTB)
#define PG8_STAGE(bufoff, gbase, voff) do { _Pragma("unroll") for (int _i = 0; _i < 2; ++_i) \
        __builtin_amdgcn_global_load_lds((const unsigned*)(wsb + (size_t)((gbase) + (voff)[_i])), (LAS unsigned*)(lds + (bufoff) + ldsw + _i * 8192), 16, 0, 0); } while (0)
#define PG8_LDA(dst, b, h) do { _Pragma("unroll") for (int m = 0; m < 4; ++m) _Pragma("unroll") for (int k = 0; k < 2; ++k) dst[m][k] = *(const LAS bf16x8*)(lds + PG8_SA(b, h) + aoff + m * 2048 + k * 1024); } while (0)
#define PG8_LDB(dst, b, h) do { _Pragma("unroll") for (int n = 0; n < 2; ++n) _Pragma("unroll") for (int k = 0; k < 2; ++k) dst[n][k] = *(const LAS bf16x8*)(lds + PG8_SB(b, h) + boff + n * 2048 + k * 1024); } while (0)
#define PG8_CAT8(x_) __builtin_shufflevector(__builtin_bit_cast(i32x4, x_[0]), __builtin_bit_cast(i32x4, x_[1]), 0, 1, 2, 3, 4, 5, 6, 7)
#define PG8_MMA(ai, bj, At, Bt) do { __builtin_amdgcn_s_setprio(1); _Pragma("unroll") for (int m = 0; m < 4; ++m) _Pragma("unroll") for (int n = 0; n < 2; ++n) { \
        if constexpr (F8) acc[ai][bj][m][n] = __builtin_amdgcn_mfma_scale_f32_16x16x128_f8f6f4(PG8_CAT8(Bt[n]), PG8_CAT8(At[m]), acc[ai][bj][m][n], 0, 0, 0, 0, 0, 0); \
        else { _Pragma("unroll") for (int k = 0; k < 2; ++k) acc[ai][bj][m][n] = __builtin_amdgcn_mfma_f32_16x16x32_bf16(Bt[n][k], At[m][k], acc[ai][bj][m][n], 0, 0, 0); } } __builtin_amdgcn_s_setprio(0); } while (0)
#define PG8_WAIT_V(n) asm volatile("s_waitcnt vmcnt(" #n ")" ::: "memory")
#define PG8_WAIT_L(n) asm volatile("s_waitcnt lgkmcnt(" #n ")" ::: "memory")
#define PG8_BAR __builtin_amdgcn_s_barrier()
#define PG8_SCHED __builtin_amdgcn_sched_barrier(0)
    Unit cur, nxt; int ui = 0;
    if (!S.next(0, cur)) return;
    f32x4 acc[2][2][4][2];
#pragma unroll
    for (int a = 0; a < 2; ++a)
#pragma unroll
        for (int b = 0; b < 2; ++b)
#pragma unroll
            for (int m = 0; m < 4; ++m)
#pragma unroll
                for (int n = 0; n < 2; ++n) acc[a][b][m][n] = (f32x4){0.f, 0.f, 0.f, 0.f};
    bf16x8 At[4][2], B0[2][2], B1[2][2];
    unsigned cA = cur.a, cB = cur.b;
    unsigned chA = HALF * cur.rsa, chB = HALF * cur.rsb;
    unsigned cvA[2], cvB[2];
    PG8_VOFF(cvA, cvB, cur.rsa, cur.rsb, cur.bswz);
    if (wid < 4) E.prefetch(cur, lds, 0, wid);
    PG8_STAGE(PG8_SB(0, 0), cB, cvB); PG8_STAGE(PG8_SB(0, 1), cB + chB, cvB); PG8_STAGE(PG8_SA(0, 0), cA, cvA); PG8_STAGE(PG8_SA(0, 1), cA + chA, cvA);
    if (wr == 1) PG8_BAR;
    PG8_WAIT_V(2); PG8_BAR;
    PG8_STAGE(PG8_SB(1, 0), cB + kstep, cvB); PG8_STAGE(PG8_SA(1, 0), cA + kstep, cvA); PG8_STAGE(PG8_SB(1, 1), cB + chB + kstep, cvB);
    PG8_WAIT_V(6); PG8_BAR;
    for (;;) {
        const bool has_next = S.next(ui + 1, nxt);
        const unsigned nA = has_next ? nxt.a : cA, nB = has_next ? nxt.b : cB;
        const unsigned nrsa = has_next ? nxt.rsa : cur.rsa, nrsb = has_next ? nxt.rsb : cur.rsb, nbswz = has_next ? nxt.bswz : cur.bswz;
        const unsigned nhA = HALF * nrsa, nhB = HALF * nrsb;
        for (int t = 0; t < nt; t += 2) {
            const bool last = (t == nt - 2);
            const unsigned a1 = cA + (unsigned)(t + 1) * kstep;
            const unsigned a2 = last ? nA : cA + (unsigned)(t + 2) * kstep, b2 = last ? nB : cB + (unsigned)(t + 2) * kstep;
            const unsigned a3 = a2 + kstep, b3 = b2 + kstep;
            const unsigned hA2 = last ? nhA : chA, hB2 = last ? nhB : chB;
            unsigned vA2[2], vB2[2];
            if (last) { PG8_VOFF(vA2, vB2, nrsa, nrsb, nbswz); } else { vA2[0] = cvA[0]; vA2[1] = cvA[1]; vB2[0] = cvB[0]; vB2[1] = cvB[1]; }
            PG8_LDB(B0, 0, 0); PG8_LDB(B1, 0, 1); PG8_SCHED; PG8_LDA(At, 0, 0); PG8_STAGE(PG8_SA(1, 1), a1 + chA, cvA);
            PG8_WAIT_V(8); PG8_WAIT_L(0); PG8_BAR; PG8_MMA(0, 0, At, B0); PG8_MMA(0, 1, At, B1); PG8_BAR; PG8_SCHED;
            PG8_LDA(At, 0, 1); PG8_STAGE(PG8_SB(0, 0), b2, vB2); PG8_STAGE(PG8_SB(0, 1), b2 + hB2, vB2); PG8_STAGE(PG8_SA(0, 0), a2, vA2);
            PG8_WAIT_V(8); PG8_WAIT_L(0); PG8_BAR; PG8_MMA(1, 0, At, B0); PG8_MMA(1, 1, At, B1); PG8_BAR; PG8_SCHED;
            PG8_LDB(B0, 1, 0); PG8_LDB(B1, 1, 1); PG8_SCHED; PG8_LDA(At, 1, 0); PG8_STAGE(PG8_SA(0, 1), a2 + hA2, vA2);
            PG8_WAIT_V(8); PG8_WAIT_L(0); PG8_BAR; PG8_MMA(0, 0, At, B0); PG8_MMA(0, 1, At, B1); PG8_BAR; PG8_SCHED;
            PG8_LDA(At, 1, 1); PG8_STAGE(PG8_SB(1, 0), b3, vB2); PG8_STAGE(PG8_SB(1, 1), b3 + hB2, vB2); PG8_STAGE(PG8_SA(1, 0), a3, vA2);
            PG8_WAIT_V(8); PG8_WAIT_L(0); PG8_BAR; PG8_MMA(1, 0, At, B0); PG8_MMA(1, 1, At, B1); PG8_BAR; PG8_SCHED;
        }
        if constexpr (ALIGN_EPI) { if (wr == 0) PG8_BAR; }
        { const int te_ = lane_id(); E(acc, cur, wr, wc, te_ & 15, te_ >> 4, lds, ui & 1); }
        if (!has_next) break;
#pragma unroll
        for (int a = 0; a < 2; ++a)
#pragma unroll
            for (int b = 0; b < 2; ++b)
#pragma unroll
                for (int m = 0; m < 4; ++m)
#pragma unroll
                    for (int n = 0; n < 2; ++n) acc[a][b][m][n] = (f32x4){0.f, 0.f, 0.f, 0.f};
        cur = nxt; cA = nA; cB = nB; chA = nhA; chB = nhB; ++ui;
        PG8_VOFF(cvA, cvB, cur.rsa, cur.rsb, cur.bswz);
        if (wid < 4) E.prefetch(cur, lds, ui & 1, wid);
        if constexpr (ALIGN_EPI) { if (wr == 1) PG8_BAR; }
    }
    PG8_WAIT_V(0);
    if constexpr (!ALIGN_EPI) { if (wr == 0) PG8_BAR; }
    PG8_BAR;
#undef PG8_VOFF
#undef PG8_SA
#undef PG8_SB
#undef PG8_STAGE
#undef PG8_LDA
#undef PG8_LDB
#undef PG8_MMA
#undef PG8_CAT8
#undef PG8_WAIT_V
#undef PG8_WAIT_L
#undef PG8_BAR
#undef PG8_SCHED
}
}

constexpr size_t MiB = 1u << 20;
constexpr size_t WS_CTL = 0, CTL_ZERO_BYTES = 64 * 1024;
constexpr size_t WS_ROPE = 1 * MiB;
constexpr size_t WS_XSS = 3 * MiB;
constexpr size_t WS_VSS = 4 * MiB;
constexpr size_t WS_LSE = 5 * MiB;
constexpr size_t WS_WM = 5 * MiB + 768 * 1024;
constexpr size_t WS_W = 8 * MiB;
constexpr size_t WS_XB = 30 * MiB;
constexpr unsigned XBP = D + 64, XBPB = XBP * 2;
constexpr size_t WS_XB8 = 8 * MiB;
constexpr unsigned XB8P = D + 128;
constexpr size_t WS_BIG = 64 * MiB;
constexpr size_t WS_END = 256 * MiB;
constexpr int CW_BAR = 1024;

constexpr int RING_BYTES = 131072;
constexpr int LDSCTL_OFF = RING_BYTES, MISC_OFF = 151552 - 256;
constexpr int XCH_OFF = LDSCTL_OFF;
constexpr int RXL_OFF = XCH_OFF + 8192;
constexpr int LDS_BYTES = 151552;
constexpr int NWAVES = 8;

typedef GAS unsigned gu32;
#define RLX_AGENT __ATOMIC_RELAXED, __HIP_MEMORY_SCOPE_AGENT

#define XB_TMO      128
#define XB_XCNT(j)  (256  + 64 * (j))
#define XB_XSUB(j)  (1280 + 64 * (j))
#define XB_XGEN(j)  (2304 + 64 * (j))
#define XB_TOP      3328
#define XB_TOPGEN   3392
#define XB_XLOC(j)  (3456 + 64 * (j))
#define XCD_BAR_WORDS 4480
#define XB_SPIN_CAP (1u << 18)

__device__ __forceinline__ unsigned xb_ld(unsigned* p)              { return __hip_atomic_load(p, __ATOMIC_RELAXED, __HIP_MEMORY_SCOPE_AGENT); }
__device__ __forceinline__ unsigned xb_add(unsigned* p, unsigned v) { return __hip_atomic_fetch_add(p, v, __ATOMIC_RELAXED, __HIP_MEMORY_SCOPE_AGENT); }
__device__ __forceinline__ unsigned xb_xcc_id() { return (unsigned)__builtin_amdgcn_s_getreg((3 << 11) | 20) & 0xFu; }
#define XB_SPIN(cond, bar) do { unsigned _sp = 0; while (cond) { __builtin_amdgcn_s_sleep(1); \
    if ((++_sp & 255u) == 0u) { if (xb_ld(&(bar)[XB_TMO])) break; if (_sp > XB_SPIN_CAP) { atomicAdd(&(bar)[XB_TMO], 1u); break; } } } } while (0)

struct XcdBarrier {
    unsigned* bar; unsigned x;
    volatile LAS unsigned* st;
};

__device__ __forceinline__ XcdBarrier xcd_barrier_post(unsigned* bar, volatile LAS unsigned* st) {
    XcdBarrier b; b.bar = bar; b.x = xb_xcc_id(); b.st = st;
    if (threadIdx.x == 0) st[2] = xb_add(&bar[XB_XCNT(b.x)], 1u);
    return b;
}
__device__ __forceinline__ void xcd_barrier_complete(unsigned* bar, unsigned x, unsigned& nloc, unsigned& nx, unsigned& xinfo) {
    const unsigned G = gridDim.x * gridDim.y * gridDim.z;
    unsigned sum, cnt, mine, sp = 0u;
    for (;;) {
        sum = 0u; cnt = 0u; mine = 0u;
#pragma unroll
        for (unsigned j = 0; j < 16; ++j) { const unsigned c = xb_ld(&bar[XB_XCNT(j)]); sum += c; cnt += (c > 0u) ? 1u : 0u; mine = (j == x) ? c : mine; }
        if (sum == G) break;
        __builtin_amdgcn_s_sleep(1);
        if ((++sp & 255u) == 0u) { if (xb_ld(&bar[XB_TMO])) break; if (sp > XB_SPIN_CAP) { atomicAdd(&bar[XB_TMO], 1u); break; } }
    }
    nloc = mine > 0u ? mine : 1u; nx = cnt > 0u ? cnt : 1u;
    unsigned below = 0u, uneq = 0u;
#pragma unroll
    for (unsigned j = 0; j < 16; ++j) { const unsigned c = xb_ld(&bar[XB_XCNT(j)]); below += (c > 0u && j < x) ? 1u : 0u; uneq += (c > 0u && c != mine) ? 1u : 0u; }
    xinfo = below | ((uneq == 0u && sum == G && cnt == 8u && cnt * mine == G) ? 256u : 0u);
}

__device__ __forceinline__ void xcd_barrier(const XcdBarrier& b, const int wave) {
    asm volatile("s_waitcnt vmcnt(0)" ::: "memory");
    __syncthreads();
    if (wave == 1 && lane_id() == 0) {
        __builtin_amdgcn_fence(__ATOMIC_ACQUIRE, "agent");
        asm volatile("s_waitcnt vmcnt(0)" ::: "memory");
    }
    if (wave == 0 && lane_id() == 0) {
        unsigned* bar = b.bar;
        __builtin_amdgcn_s_waitcnt(0);
        unsigned nloc = b.st[0], nx = b.st[1];
        if (nloc == 0u) { unsigned xi_; xcd_barrier_complete(bar, b.x, nloc, nx, xi_); b.st[0] = nloc; b.st[1] = nx; b.st[3] = xi_; }
        const unsigned old = xb_add(&bar[XB_XSUB(b.x)], 1u);
        const unsigned gen = old / nloc;
        if (old + 1u == (gen + 1u) * nloc) {
            __builtin_amdgcn_fence(__ATOMIC_RELEASE, "agent");
            asm volatile("s_waitcnt vmcnt(0)" ::: "memory");
            const unsigned og = xb_add(&bar[XB_TOP], 1u);
            const unsigned tg = og / nx;
            if (og + 1u == (tg + 1u) * nx) {
#pragma unroll
                for (unsigned j = 0; j < 16; ++j) (void)xb_add(&bar[XB_XGEN(j)], 1u);
            }
        }
        XB_SPIN(xb_ld(&bar[XB_XGEN(b.x)]) == gen, bar);
        asm volatile("s_waitcnt vmcnt(0)" ::: "memory");
    }
    __syncthreads();
}

__device__ __forceinline__ void xcd_local_barrier(const XcdBarrier& b, const int wave) {
    asm volatile("s_waitcnt vmcnt(0)" ::: "memory");
    __syncthreads();
    if (wave == 1 && lane_id() == 0) {
        __builtin_amdgcn_fence(__ATOMIC_ACQUIRE, "agent");
        asm volatile("s_waitcnt vmcnt(0)" ::: "memory");
    }
    if (wave == 0 && lane_id() == 0) {
        unsigned* bar = b.bar;
        __builtin_amdgcn_s_waitcnt(0);
        const unsigned nloc = b.st[0];
        const unsigned old = xb_add(&bar[XB_XLOC(b.x)], 1u);
        const unsigned tgt = (old / nloc + 1u) * nloc;
        if (old + 1u != tgt) XB_SPIN(xb_ld(&bar[XB_XLOC(b.x)]) < tgt, bar);
        asm volatile("s_waitcnt vmcnt(0)" ::: "memory");
    }
    __syncthreads();
}


struct Args { const float* in[15]; float* out; unsigned char* ws; };
struct Frame {
    LAS unsigned char* lds;
    int tid, lane, wave, vcu, G;
    unsigned char* ws;
};

constexpr float F8_WMUL = 64.f, F8_WINV = 1.f / 64.f;
template <bool F8 = false>
__device__ __forceinline__ void transpose_item(const float* __restrict__ W, int ldw, int K, const float* __restrict__ gain, bf16* WT, int nsrc0, int ndst0, int k0, LAS float* scr, int lane, bool live = true, int src_lane_col = -1) {
    f32x4 v[8]; float gk[8];
    const int kr = lane >> 3, n4 = (lane & 7) * 4;
#pragma unroll
    for (int i = 0; i < 8; ++i) { v[i] = *(const f32x4*)(W + (size_t)(k0 + kr + 8 * i) * ldw + (src_lane_col >= 0 ? src_lane_col : nsrc0 + n4)); gk[i] = (gain ? gain[k0 + kr + 8 * i] : 1.f) * (F8 ? F8_WMUL : 1.f); }
#pragma unroll
    for (int i = 0; i < 8; ++i) { LAS float* d = scr + (kr + 8 * i) * 33 + n4; d[0] = v[i][0] * gk[i]; d[1] = v[i][1] * gk[i]; d[2] = v[i][2] * gk[i]; d[3] = v[i][3] * gk[i]; }
    LDS_WAIT(); asm volatile("" ::: "memory");
    const int c = lane & 7;
#pragma unroll
    for (int j = 0; j < 4; ++j) { const int n = (lane >> 3) + 8 * j; const LAS float* s = scr + (8 * c) * 33 + n;
        if constexpr (F8) { u32x2 o; o.x = pk8(s[0 * 33], s[1 * 33], s[2 * 33], s[3 * 33]); o.y = pk8(s[4 * 33], s[5 * 33], s[6 * 33], s[7 * 33]);
            if (live) *(u32x2*)((unsigned char*)WT + (size_t)(ndst0 + n) * K + k0 + 8 * c) = o; }
        else { u32x4 o; o.x = cvtpk(s[0 * 33], s[1 * 33]); o.y = cvtpk(s[2 * 33], s[3 * 33]); o.z = cvtpk(s[4 * 33], s[5 * 33]); o.w = cvtpk(s[6 * 33], s[7 * 33]);
            if (live) *(u32x4*)(WT + (size_t)(ndst0 + n) * K + k0 + 8 * c) = o; } }
    LDS_WAIT(); asm volatile("" ::: "memory");
}

__device__ __forceinline__ void x_rows_prep2(const float* xrow, bf16* orow, float* xss, int lane, bool live = true) {
    const f32x4* xr = (const f32x4*)xrow + lane;
    f32x4 v[2][4]; float s[2] = {0.f, 0.f};
#pragma unroll
    for (int r = 0; r < 2; ++r)
#pragma unroll
        for (int j = 0; j < 4; ++j) v[r][j] = xr[r * (D / 4) + 64 * j];
#pragma unroll
    for (int r = 0; r < 2; ++r) {
#pragma unroll
        for (int j = 0; j < 4; ++j) s[r] += (v[r][j].x * v[r][j].x + v[r][j].y * v[r][j].y) + (v[r][j].z * v[r][j].z + v[r][j].w * v[r][j].w);
        const float tot = wave_sum(s[r]);
        u32x2* o8 = (u32x2*)(orow + (size_t)r * XBP) + lane;
#pragma unroll
        for (int j = 0; j < 4; ++j) { u32x2 w; w.x = cvtpk(v[r][j].x, v[r][j].y); w.y = cvtpk(v[r][j].z, v[r][j].w); if (live) o8[64 * j] = w; }
        if (lane == 0 && live) *(f32x4*)(xss + 4 * r) = (f32x4){tot, 0.f, 0.f, 0.f};
    }
}

constexpr size_t WA_IN = 194 * MiB, WA_OUT = WA_IN + (size_t)AIN * D * 2;
constexpr size_t BA_G = WS_BIG, BA_VT = WS_BIG + (size_t)M * AW * 2;
constexpr int VTS = M + 64;

__device__ __forceinline__ void a_convert_weights(const Frame& F, const float* w_in, const float* ngain, const float* w_out, const float* w_s, bool live = true) {
    { bf16* Wm = (bf16*)(F.ws + WS_WM);
      for (int q = F.vcu * 512 + F.tid; q < 8 * 128 * 16; q += F.G * 512) { const int i = (q >> 4) & 127, j0 = (q & 15) * 8; const f32x4 a = *(const f32x4*)(w_s + (size_t)q * 8), b = *(const f32x4*)(w_s + (size_t)q * 8 + 4);
        u32x4 o; o.x = cvtpk(j0 + 0 <= i ? a[0] : 0.f, j0 + 1 <= i ? a[1] : 0.f); o.y = cvtpk(j0 + 2 <= i ? a[2] : 0.f, j0 + 3 <= i ? a[3] : 0.f);
        o.z = cvtpk(j0 + 4 <= i ? b[0] : 0.f, j0 + 5 <= i ? b[1] : 0.f); o.w = cvtpk(j0 + 6 <= i ? b[2] : 0.f, j0 + 7 <= i ? b[3] : 0.f); if (live) *(u32x4*)(Wm + (size_t)q * 8) = o; } }
    LAS float* scr = (LAS float*)(F.lds + F.wave * 16384);
    const int gw = F.vcu * NWAVES + F.wave, NGW = F.G * NWAVES;
    constexpr int I_IN = (D / 64) * (AIN / 32), I_OUT = (AW / 64) * (D / 32);
    bf16* WinT = (bf16*)(F.ws + WA_IN); bf16* WoT = (bf16*)(F.ws + WA_OUT);
    for (int it = gw; it < I_IN + I_OUT; it += NGW) {
        if (it < I_IN) {
            const int nb = it % (AIN / 32), kb = it / (AIN / 32), nd = 32 * nb;
            int ns;
            if (nd < 4096) { const int t = nd >> 8, w = nd & 255; ns = (w < 128) ? (128 * t + w) : (2 * AW + 128 * t + (w - 128)); }
            else ns = AW + (nd - 4096);
            transpose_item(w_in, AIN, D, ngain, WinT, ns, nd, 64 * kb, scr, F.lane, live);
        } else {
            const int r = it - I_IN, nb = r % (D / 32), kb = r / (D / 32);
            transpose_item(w_out, D, AW, nullptr, WoT, 32 * nb, 32 * nb, 64 * kb, scr, F.lane, live);
        }
    }
}

__device__ __forceinline__ void xss_prefetch256(const float* xss_row0, LAS unsigned char* lds, int par, int w) {
    const int l = lane_id();
    __builtin_amdgcn_global_load_lds((const unsigned*)(xss_row0 + (size_t)(64 * w + l) * 4), (LAS unsigned*)(lds + RXL_OFF + par * 4096 + w * 1024), 16, 0, 0);
}
__device__ __forceinline__ float rx_of(const LAS float* xl, int i) { const f32x4 p = *(const LAS f32x4*)(xl + 4 * i); return __builtin_amdgcn_rsqf(((p[0] + p[1]) + (p[2] + p[3])) * (1.f / D) + EPS); }
struct SchedA1 {
    pg8::TileOrder Tv, Tu; unsigned XB, W; int nv;
    __device__ __forceinline__ void init(int G, int c) { Tv.init(M / 256, 8, G, c); Tu.init(M / 256, 16, G, c); nv = (Tv.nwg - c + G - 1) / G; if (nv < 0) nv = 0; }
    __device__ __forceinline__ bool has_uz() const { return Tu.c < Tu.nwg; }
    __device__ __forceinline__ bool next(int i, pg8::Unit& u) const {
        u.bswz = 0;
        if (i < nv) { if (!Tv.tile(i, u.pm, u.pn)) return false; u.pn += 16; } else { if (!Tu.tile(i - nv, u.pm, u.pn)) return false; }
        const unsigned x = XB + (unsigned)u.pm * 256u * XBPB, w = W + (unsigned)u.pn * 256u * (D * 2);
        if (u.pn < 16) { u.a = x; u.b = w; u.rsa = XBPB; u.rsb = D * 2; u.kind = (i == nv) ? 2 : 0; } else { u.a = w; u.b = x; u.rsa = D * 2; u.rsb = XBPB; u.kind = 1; }
        return true;
    }
};
struct EpiA1 {
    static constexpr bool PERM = true;
    bf16* Gm; bf16* VT; const float* XSS; float* VSS; bool live; const bf16* Wm; const float* bs; const float* vgain; const XcdBarrier* gbar; bool bar_local;
    __device__ __forceinline__ void prefetch(const pg8::Unit& u, LAS unsigned char* lds, int par, int w) const { if (u.kind != 99) xss_prefetch256(XSS + (size_t)u.pm * 256 * 4, lds, par, w); }
    __device__ __forceinline__ void operator()(const f32x4 (&acc)[2][2][4][2], const pg8::Unit& u, int wr, int wc, int fr, int fq, LAS unsigned char* lds, int par) const {
        const LAS float* XL = (const LAS float*)(lds + RXL_OFF + par * 4096);
        asm volatile("" : "+v"(fr), "+v"(fq));
        if (u.kind == 2) { if (bar_local) xcd_local_barrier(*gbar, wr * 4 + wc); else xcd_barrier(*gbar, wr * 4 + wc); }
        if (u.kind == 0 || u.kind == 2) {
            const int row0 = u.pm * 256 + wr * 64 + fr, col0 = u.pn * 128 + wc * 32 + 8 * fq, g = u.pn >> 1;
            LAS float* T = (LAS float*)(lds + XCH_OFF);
            float pv[16];
            if (wr == 0) {
#pragma unroll
                for (int p = 0; p < 16; ++p) pv[p] = VSS[(size_t)p * M + u.pm * 256 + wc * 64 + fq * 16 + fr];
            }
            u32x4 vf[2][4][2];
            const bf16* vp = VT + (size_t)(u.pn * 128 + wc * 32 + 8 * (fr >> 2) + (fr & 3)) * VTS + u.pm * 256 + 8 * fq;
#define A1_VLOAD(ai_) do { _Pragma("unroll") for (int ks = 0; ks < 4; ++ks) _Pragma("unroll") for (int n = 0; n < 2; ++n) vf[ai_][ks][n] = *(const u32x4*)(vp + (size_t)(4 * n) * VTS + (ai_) * 128 + ks * 32); } while (0)
            A1_VLOAD(0);
            const f32x4 vg0 = *(const f32x4*)(vgain + col0), vg1 = *(const f32x4*)(vgain + col0 + 4);
            const bf16* wp = Wm + ((size_t)(g * 128 + wr * 64 + fr) * 128 + 8 * fq);
            float bsv[4];
            { const float* bp = bs + g * 128 + wr * 64 + fr;
#pragma unroll
              for (int m = 0; m < 4; ++m) bsv[m] = bp[16 * m]; }
            u32x4 wf[4][4];
#define A1_WLOAD(m_) do { _Pragma("unroll") for (int ks = 0; ks < 4; ++ks) if (ks <= 2 * wr + ((m_) >> 1)) wf[m_][ks] = *(const u32x4*)(wp + (size_t)(16 * (m_)) * 128 + 32 * ks); } while (0)
            u32x2 gv[2][4][2];
#pragma unroll
            for (int ai = 0; ai < 2; ++ai)
#pragma unroll
                for (int m = 0; m < 4; ++m) {
                    const float rx = rx_of(XL, ai * 128 + wr * 64 + m * 16 + fr);
#pragma unroll
                    for (int n = 0; n < 2; ++n) { float g_[4];
#pragma unroll
                        for (int e = 0; e < 4; ++e) g_[e] = (acc[ai][0][m][n][e] * rx) * silu_f(acc[ai][1][m][n][e] * rx);
                        unsigned lo_ = cvtpk(g_[0], g_[1]), hi_ = cvtpk(g_[2], g_[3]); asm volatile("" : "+v"(lo_), "+v"(hi_));
                        gv[ai][m][n] = (u32x2){lo_, hi_}; }
                }
            __builtin_amdgcn_sched_barrier(0);
            A1_VLOAD(1);
            A1_WLOAD(0); A1_WLOAD(1); A1_WLOAD(2); A1_WLOAD(3);
            if (wr == 0) { float s_ = 0.f;
#pragma unroll
                for (int p = 0; p < 16; ++p) s_ += pv[p];
                T[wc * 64 + fq * 16 + fr] = __builtin_amdgcn_rsqf(s_ * (1.f / AW) + EPS); }
            LDS_WAIT(); __builtin_amdgcn_s_barrier(); asm volatile("" : "+v"(fr), "+v"(fq) :: "memory");
#pragma unroll
            for (int ai = 0; ai < 2; ++ai) {
#pragma unroll
                for (int ks = 0; ks < 4; ++ks) {
                    const f32x4 r0 = *(const LAS f32x4*)(T + ai * 128 + ks * 32 + 8 * fq), r1 = *(const LAS f32x4*)(T + ai * 128 + ks * 32 + 8 * fq + 4);
#pragma unroll
                    for (int n = 0; n < 2; ++n) { const u32x4 w_ = vf[ai][ks][n]; u32x4 o_;
                        o_.x = cvtpk(bf_lo(w_.x) * r0[0], bf_hi(w_.x) * r0[1]); o_.y = cvtpk(bf_lo(w_.y) * r0[2], bf_hi(w_.y) * r0[3]);
                        o_.z = cvtpk(bf_lo(w_.z) * r1[0], bf_hi(w_.z) * r1[1]); o_.w = cvtpk(bf_lo(w_.w) * r1[2], bf_hi(w_.w) * r1[3]); vf[ai][ks][n] = o_; }
                }
#pragma unroll
                for (int m = 0; m < 4; ++m) {
                    f32x4 d0 = (f32x4){0.f, 0.f, 0.f, 0.f}, d1 = (f32x4){0.f, 0.f, 0.f, 0.f};
#pragma unroll
                    for (int ks = 0; ks < 4; ++ks) if (ks <= 2 * wr + (m >> 1)) {
                        const bf16x8 wb = __builtin_bit_cast(bf16x8, wf[m][ks]);
                        d0 = __builtin_amdgcn_mfma_f32_16x16x32_bf16(__builtin_bit_cast(bf16x8, vf[ai][ks][0]), wb, d0, 0, 0, 0);
                        d1 = __builtin_amdgcn_mfma_f32_16x16x32_bf16(__builtin_bit_cast(bf16x8, vf[ai][ks][1]), wb, d1, 0, 0, 0);
                    }
                    const u32x2 ga = gv[ai][m][0], gb = gv[ai][m][1];
                    const f32x4 y0 = (f32x4){bf_lo(ga.x), bf_hi(ga.x), bf_lo(ga.y), bf_hi(ga.y)} * (vg0 * d0 + bsv[m]), y1 = (f32x4){bf_lo(gb.x), bf_hi(gb.x), bf_lo(gb.y), bf_hi(gb.y)} * (vg1 * d1 + bsv[m]);
                    u32x4 w; w.x = cvtpk(y0[0], y0[1]); w.y = cvtpk(y0[2], y0[3]); w.z = cvtpk(y1[0], y1[1]); w.w = cvtpk(y1[2], y1[3]);
                    if (live) *(u32x4*)(Gm + (size_t)(row0 + ai * 128 + m * 16) * AW + col0) = w;
                }
            }
#undef A1_WLOAD
#undef A1_VLOAD
        } else if (u.kind == 1) {
            const int ch0 = (u.pn - 16) * 256 + wr * 64 + fr, t0 = u.pm * 256 + wc * 32 + 8 * fq;
            f32x4 rxv[2][2], ss[2][2];
#pragma unroll
            for (int bj = 0; bj < 2; ++bj)
#pragma unroll
                for (int n = 0; n < 2; ++n) { const int c_ = wc * 32 + 8 * fq + bj * 128 + 4 * n; rxv[bj][n] = (f32x4){rx_of(XL, c_), rx_of(XL, c_ + 1), rx_of(XL, c_ + 2), rx_of(XL, c_ + 3)}; ss[bj][n] = (f32x4){0.f, 0.f, 0.f, 0.f}; }
#pragma unroll
            for (int ai = 0; ai < 2; ++ai)
#pragma unroll
                for (int m = 0; m < 4; ++m) {
                    const int ch = ch0 + ai * 128 + m * 16;
#pragma unroll
                    for (int bj = 0; bj < 2; ++bj) {
                        const f32x4 v0 = acc[ai][bj][m][0] * rxv[bj][0], v1 = acc[ai][bj][m][1] * rxv[bj][1];
                        ss[bj][0] += v0 * v0; ss[bj][1] += v1 * v1;
                        u32x4 w; w.x = cvtpk(v0[0], v0[1]); w.y = cvtpk(v0[2], v0[3]); w.z = cvtpk(v1[0], v1[1]); w.w = cvtpk(v1[2], v1[3]);
                        if (live) *(u32x4*)(VT + (size_t)ch * VTS + t0 + bj * 128) = w;
                    }
                }
#pragma unroll
            for (int bj = 0; bj < 2; ++bj)
#pragma unroll
                for (int n = 0; n < 2; ++n)
#pragma unroll
                    for (int e = 0; e < 4; ++e) ss[bj][n][e] = row16_sum(ss[bj][n][e]);
            if (fr == 0 && live) {
                const int p = (u.pn - 16) * 2 + wr;
#pragma unroll
                for (int bj = 0; bj < 2; ++bj)
#pragma unroll
                    for (int n = 0; n < 2; ++n) *(f32x4*)(VSS + (size_t)p * M + t0 + bj * 128 + 4 * n) = ss[bj][n];
            }
        }
    }
};

struct SchedOut {
    pg8::TileOrder T; unsigned Y, W, kbytes;
    __device__ __forceinline__ bool next(int i, pg8::Unit& u) const {
        if (!T.tile(i, u.pm, u.pn)) return false; u.bswz = 0;
        u.a = Y + (unsigned)u.pm * 256u * kbytes; u.b = W + (unsigned)u.pn * 256u * kbytes; u.rsa = kbytes; u.rsb = kbytes; u.kind = 0; return true;
    }
};
struct EpiOut {
    static constexpr bool PERM = true;
    const float* xf32; bf16* XR; float* XSS; float* outf32; bool live; unsigned char* X8;
    __device__ __forceinline__ void prefetch(const pg8::Unit&, LAS unsigned char*, int, int) const {}
    __device__ __forceinline__ void operator()(const f32x4 (&acc)[2][2][4][2], const pg8::Unit& u, int wr, int wc, int fr, int fq, LAS unsigned char* lds, int) const {
        LAS float* T = (LAS float*)(lds + XCH_OFF);
        asm volatile("" : "+v"(fr), "+v"(fq));
        const int row0 = u.pm * 256 + wr * 64 + fr, col0 = u.pn * 256 + wc * 32 + 8 * fq;
        f32x4 pf[2][2][2]; u32x4 pb[2][2];
#define EO_ROW(k_) (row0 + ((k_) >> 2) * 128 + ((k_) & 3) * 16)
#define EO_LOAD(k_) do { const int r_ = EO_ROW(k_); _Pragma("unroll") for (int bj = 0; bj < 2; ++bj) { \
            if (xf32) { const f32x4* p_ = (const f32x4*)(xf32 + (size_t)r_ * D + col0 + bj * 128); pf[(k_) & 1][bj][0] = p_[0]; pf[(k_) & 1][bj][1] = p_[1]; } \
            else pb[(k_) & 1][bj] = *(const u32x4*)(XR + (size_t)r_ * XBP + col0 + bj * 128); } } while (0)
#define EO_STORE(k_) do { const int r_ = EO_ROW(k_); float s_ = 0.f; _Pragma("unroll") for (int bj = 0; bj < 2; ++bj) { f32x4 o0, o1; \
            if (xf32) { o0 = pf[(k_) & 1][bj][0]; o1 = pf[(k_) & 1][bj][1]; } \
            else { const u32x4 w_ = pb[(k_) & 1][bj]; o0 = (f32x4){bf_lo(w_.x), bf_hi(w_.x), bf_lo(w_.y), bf_hi(w_.y)}; o1 = (f32x4){bf_lo(w_.z), bf_hi(w_.z), bf_lo(w_.w), bf_hi(w_.w)}; } \
            o0 += acc[(k_) >> 2][bj][(k_) & 3][0]; o1 += acc[(k_) >> 2][bj][(k_) & 3][1]; \
            if (outf32) { if (live) { f32x4* q_ = (f32x4*)(outf32 + (size_t)r_ * D + col0 + bj * 128); q_[0] = o0; q_[1] = o1; } } \
            else { u32x4 w_; w_.x = cvtpk(o0[0], o0[1]); w_.y = cvtpk(o0[2], o0[3]); w_.z = cvtpk(o1[0], o1[1]); w_.w = cvtpk(o1[2], o1[3]); if (live) *(u32x4*)(XR + (size_t)r_ * XBP + col0 + bj * 128) = w_; \
                   if (X8) { u32x2 b_; b_.x = pk8(o0[0], o0[1], o0[2], o0[3]); b_.y = pk8(o1[0], o1[1], o1[2], o1[3]); if (live) *(u32x2*)(X8 + (size_t)r_ * XB8P + col0 + bj * 128) = b_; } \
                   s_ += ((o0[0] * o0[0] + o0[1] * o0[1]) + (o0[2] * o0[2] + o0[3] * o0[3])) + ((o1[0] * o1[0] + o1[1] * o1[1]) + (o1[2] * o1[2] + o1[3] * o1[3])); } } \
            if (!outf32) { s_ = sum_x32(sum_x16(s_)); if (fq == 0) T[(r_ - u.pm * 256) * 4 + wc] = s_; } } while (0)
        EO_LOAD(0); EO_LOAD(1);
#pragma unroll
        for (int k = 0; k < 8; ++k) { EO_STORE(k); if (k + 2 < 8) EO_LOAD(k + 2); }
        if (!outf32) {
            LDS_WAIT(); __builtin_amdgcn_s_barrier(); asm volatile("" ::: "memory");
            const int t_ = (wr * 4 + wc) * 64 + fq * 16 + fr;
            if (t_ < 256) { const f32x4 p = *(const LAS f32x4*)(T + 4 * t_); if (live) XSS[(size_t)(u.pm * 256 + t_) * 4 + u.pn] = (p[0] + p[1]) + (p[2] + p[3]); }
        }
#undef EO_ROW
#undef EO_LOAD
#undef EO_STORE
    }
};


constexpr size_t WC_IN = 240 * MiB, WC_OUT = 248 * MiB, WC_NAT = 252 * MiB, WC_GT = 6 * MiB;
constexpr size_t BC_X = WS_BIG, BC_Z = WS_BIG + (size_t)M * CW * 2;

__device__ __forceinline__ void c_convert_fold_inputs(const Frame& F, const float* w_in, const float* ngain, const float* w_grp, bool live = true) {
    LAS float* scr = (LAS float*)(F.lds + F.wave * 16384);
    const int gw = F.vcu * NWAVES + F.wave, NGW = F.G * NWAVES;
    constexpr int I_G = 4 * (512 / 64) * (512 / 32);
    bf16* WGT = (bf16*)(F.ws + WC_GT); bf16* WN = (bf16*)(F.ws + WC_NAT);
    for (int r = gw; r < I_G; r += NGW) { const int g = r >> 7, q = r & 127, nb = q & 15, kb = q >> 4;
        transpose_item(w_grp + (size_t)g * 512 * 512, 512, 512, nullptr, WGT + (size_t)g * 512 * 512, 32 * nb, 32 * nb, 64 * kb, scr, F.lane, live); }
    for (int i = F.vcu * 512 + F.tid; i < D * CW / 8; i += F.G * 512) {
        const int k = i >> 8, c = (i & 255) * 8; const float gk = ngain[k];
        const f32x4 a = *(const f32x4*)(w_in + (size_t)k * CIN + c), b = *(const f32x4*)(w_in + (size_t)k * CIN + c + 4);
        u32x4 o; o.x = cvtpk(a[0] * gk, a[1] * gk); o.y = cvtpk(a[2] * gk, a[3] * gk); o.z = cvtpk(b[0] * gk, b[1] * gk); o.w = cvtpk(b[2] * gk, b[3] * gk);
        if (live) *(u32x4*)(WN + (size_t)k * CW + c) = o;
    }
}
__device__ __forceinline__ void c_convert_rest(const Frame& F, const float* w_in, const float* ngain, const float* w_out, int wi, int nw, bool live = true) {
    LAS float* scr = (LAS float*)(F.lds + F.wave * 16384);
    constexpr int I_Z = (D / 64) * (CW / 32), I_OUT = (CW / 64) * (D / 32);
    bf16* WcT = (bf16*)(F.ws + WC_IN); bf16* WoT = (bf16*)(F.ws + WC_OUT);
    for (int it = wi * NWAVES + F.wave; it < I_Z + I_OUT; it += nw * NWAVES) {
        if (it < I_Z) { const int nb = it % (CW / 32), kb = it / (CW / 32), c0 = 32 * nb; transpose_item(w_in, CIN, D, ngain, WcT, CW + c0, 256 * (c0 >> 7) + 128 + (c0 & 127), 64 * kb, scr, F.lane, live); }
        else { const int r = it - I_Z, nb = r % (D / 32), kb = r / (D / 32); transpose_item(w_out, D, CW, nullptr, WoT, 32 * nb, 32 * nb, 64 * kb, scr, F.lane, live); }
    }
}
struct SchedFold {
    int G, c;
    __device__ __forceinline__ bool next(int i, pg8::Unit& u) const {
        const int L = i * G + c; if (L >= 32) return false;
        const int g = L >> 3, dt = (L >> 2) & 1, kt = L & 3;
        u.pm = g * 2 + dt; u.pn = kt; u.kind = 0; u.bswz = 0;
        u.a = (unsigned)WC_GT + (unsigned)((g * 512 + 256 * dt) * 512) * 2u; u.rsa = 1024;
        u.b = (unsigned)WC_NAT + (unsigned)(256 * kt * CW + g * 512) * 2u; u.rsb = CW * 2;
        return true;
    }
};
struct EpiPlainBf16 {
    static constexpr bool PERM = true;
    bf16* O; int ldc; bool live; bool pair_rows;
    __device__ __forceinline__ void prefetch(const pg8::Unit&, LAS unsigned char*, int, int) const {}
    __device__ __forceinline__ void operator()(const f32x4 (&acc)[2][2][4][2], const pg8::Unit& u, int wr, int wc, int fr, int fq, LAS unsigned char*, int) const {
        asm volatile("" : "+v"(fr), "+v"(fq));
        const int row0 = u.pm * 256 + wr * 64 + fr, col0 = u.pn * 256 + wc * 32 + 8 * fq;
#pragma unroll
        for (int ai = 0; ai < 2; ++ai)
#pragma unroll
            for (int m = 0; m < 4; ++m) {
                const int rr_ = row0 + ai * 128 + m * 16; bf16* rowp = O + (size_t)(pair_rows ? rr_ + (rr_ & ~127) : rr_) * ldc + col0;
#pragma unroll
                for (int bj = 0; bj < 2; ++bj) { const f32x4 v0 = acc[ai][bj][m][0], v1 = acc[ai][bj][m][1];
                    u32x4 w; w.x = cvtpk(v0[0], v0[1]); w.y = cvtpk(v0[2], v0[3]); w.z = cvtpk(v1[0], v1[1]); w.w = cvtpk(v1[2], v1[3]);
                    if (live) *(u32x4*)(rowp + bj * 128) = w; }
            }
    }
};
struct SchedC1 {
    pg8::TileOrder T;
    __device__ __forceinline__ bool next(int i, pg8::Unit& u) const {
        const bool dry_ = false; if (!T.tile(i, u.pm, u.pn)) return false; u.bswz = 0;
        u.a = (unsigned)WS_XB + (unsigned)u.pm * 256u * XBPB; u.b = (unsigned)WC_IN + (unsigned)u.pn * 256u * (D * 2); u.rsa = XBPB; u.rsb = D * 2; u.kind = 0;
        (void)dry_; return true;
    }
};
struct EpiC1 {
    static constexpr bool PERM = true;
    bf16* XC; bf16* ZS; const float* XSS; const float* scale; bool live;
    __device__ __forceinline__ void prefetch(const pg8::Unit& u, LAS unsigned char* lds, int par, int w) const { xss_prefetch256(XSS + (size_t)u.pm * 256 * 4, lds, par, w); }
    __device__ __forceinline__ void operator()(const f32x4 (&acc)[2][2][4][2], const pg8::Unit& u, int wr, int wc, int fr, int fq, LAS unsigned char* lds, int par) const {
        const LAS float* XL = (const LAS float*)(lds + RXL_OFF + par * 4096);
        asm volatile("" : "+v"(fr), "+v"(fq));
        const int row0 = u.pm * 256 + wr * 64 + fr, col0 = u.pn * 128 + wc * 32 + 8 * fq;
        const int lev = (u.pn >> 2) + 1;
        const float invw = __builtin_amdgcn_rcpf((float)(1 << lev));
        const f32x4 sc0 = *(const f32x4*)(scale + col0), sc1 = *(const f32x4*)(scale + col0 + 4);
#pragma unroll
        for (int ai = 0; ai < 2; ++ai) {
            f32x4 xs[4][2];
#pragma unroll
            for (int m = 0; m < 4; ++m) { const float rx = rx_of(XL, ai * 128 + wr * 64 + m * 16 + fr); xs[m][0] = acc[ai][0][m][0] * rx; xs[m][1] = acc[ai][0][m][1] * rx; }
#pragma unroll
            for (int m = 0; m < 4; ++m) {
                const int r = row0 + ai * 128 + m * 16; const float rx = rx_of(XL, ai * 128 + wr * 64 + m * 16 + fr);
                f32x4 z0 = acc[ai][1][m][0] * rx, z1 = acc[ai][1][m][1] * rx;
#pragma unroll
                for (int e = 0; e < 4; ++e) { z0[e] = silu_f(z0[e]); z1[e] = silu_f(z1[e]); }
                u32x4 w;
                if (m == 0 || m == 3) { w.x = cvtpk(xs[m][0][0], xs[m][0][1]); w.y = cvtpk(xs[m][0][2], xs[m][0][3]); w.z = cvtpk(xs[m][1][0], xs[m][1][1]); w.w = cvtpk(xs[m][1][2], xs[m][1][3]);
                    if (live) *(u32x4*)(XC + (size_t)r * CW + col0) = w; }
                if (m > 0) {
                    f32x4 y0, y1;
#pragma unroll
                    for (int hq = 0; hq < 2; ++hq)
#pragma unroll
                        for (int e = 0; e < 4; ++e) {
                            float wc_ = xs[m][hq][e], wp_ = xs[m - 1][hq][e];
#define POOL_LEVEL(S_) if (lev > (S_ == 1 ? 0 : S_ == 2 ? 1 : S_ == 4 ? 2 : 3)) { const float tp_ = dpp_ror<S_>(wp_); const float shc_ = dpp_shr_old<S_>(tp_, wc_); const float shp_ = dpp_f<0x110 + S_>(wp_); wc_ += shc_; wp_ += shp_; }
                            POOL_LEVEL(1) POOL_LEVEL(2) POOL_LEVEL(4) POOL_LEVEL(8)
#undef POOL_LEVEL
                            const float yy = (wc_ * invw - xs[m][hq][e]) * (hq ? sc1[e] : sc0[e]) * (hq ? z1[e] : z0[e]);
                            if (hq) y1[e] = yy; else y0[e] = yy;
                        }
                    w.x = cvtpk(y0[0], y0[1]); w.y = cvtpk(y0[2], y0[3]); w.z = cvtpk(y1[0], y1[1]); w.w = cvtpk(y1[2], y1[3]);
                } else { w.x = cvtpk(z0[0], z0[1]); w.y = cvtpk(z0[2], z0[3]); w.z = cvtpk(z1[0], z1[1]); w.w = cvtpk(z1[2], z1[3]); }
                if (live) *(u32x4*)(ZS + (size_t)r * CW + col0) = w;
            }
        }
    }
};
__device__ __forceinline__ void c_pool_phase(const Frame& F, const float* scale, bool live = true) {
    const bf16* XC = (const bf16*)(F.ws + BC_X); bf16* ZS = (bf16*)(F.ws + BC_Z);
    const int gw = F.vcu * NWAVES + F.wave, NGW = F.G * NWAVES;
    for (int wt = gw; wt < (M / 64) * 2 * 4; wt += NGW) {
        const int seg = wt >> 2, g = wt & 3, w = 2 << g, t0 = (seg >> 1) * 64 + (seg & 1) * 8, bstart = t0 & ~(SEQ - 1), c = g * 512 + F.lane * 8;
        const f32x4 sc0 = *(const f32x4*)(scale + c), sc1 = *(const f32x4*)(scale + c + 4);
        float s[8];
#pragma unroll
        for (int e = 0; e < 8; ++e) s[e] = 0.f;
        for (int j = 1; j <= w; ++j) { const int t = t0 - j; if (t >= bstart) { const u32x4 v = *(const u32x4*)(XC + (size_t)t * CW + c);
            s[0] += bf_lo(v.x); s[1] += bf_hi(v.x); s[2] += bf_lo(v.y); s[3] += bf_hi(v.y); s[4] += bf_lo(v.z); s[5] += bf_hi(v.z); s[6] += bf_lo(v.w); s[7] += bf_hi(v.w); } }
        for (int tb = t0; tb < t0 + 8; tb += 4) {
            u32x4 xv[4], zv[4], ov[4];
#pragma unroll
            for (int i = 0; i < 4; ++i) { const int t = tb + i; xv[i] = *(const u32x4*)(XC + (size_t)t * CW + c); zv[i] = *(const u32x4*)(ZS + (size_t)t * CW + c);
                const int to = (t - w >= bstart) ? t - w : t; ov[i] = *(const u32x4*)(XC + (size_t)to * CW + c); }
#pragma unroll
            for (int i = 0; i < 4; ++i) {
                const int t = tb + i; const u32x4 v = xv[i], zz = zv[i], o = ov[i];
                const float x[8] = {bf_lo(v.x), bf_hi(v.x), bf_lo(v.y), bf_hi(v.y), bf_lo(v.z), bf_hi(v.z), bf_lo(v.w), bf_hi(v.w)};
#pragma unroll
                for (int e = 0; e < 8; ++e) s[e] += x[e];
                if (t - w >= bstart) { s[0] -= bf_lo(o.x); s[1] -= bf_hi(o.x); s[2] -= bf_lo(o.y); s[3] -= bf_hi(o.y); s[4] -= bf_lo(o.z); s[5] -= bf_hi(o.z); s[6] -= bf_lo(o.w); s[7] -= bf_hi(o.w); }
                const int cnt = (t - bstart + 1 < w) ? (t - bstart + 1) : w; const float inv = __builtin_amdgcn_rcpf((float)cnt);
                const float z[8] = {bf_lo(zz.x), bf_hi(zz.x), bf_lo(zz.y), bf_hi(zz.y), bf_lo(zz.z), bf_hi(zz.z), bf_lo(zz.w), bf_hi(zz.w)};
                float y[8];
#pragma unroll
                for (int e = 0; e < 8; ++e) y[e] = (s[e] * inv - x[e]) * ((e < 4) ? sc0[e] : sc1[e - 4]) * z[e];
                u32x4 ow; ow.x = cvtpk(y[0], y[1]); ow.y = cvtpk(y[2], y[3]); ow.z = cvtpk(y[4], y[5]); ow.w = cvtpk(y[6], y[7]);
                if (live) *(u32x4*)(ZS + (size_t)t * CW + c) = ow;
            }
        }
    }
}

constexpr size_t WB_QKZ = 240 * MiB, WB_V = 247 * MiB, WB_OUT = WS_W + 20 * MiB;
constexpr size_t WS_GP = 96 * 1024;
__host__ __device__ __forceinline__ int pi4(int Gp) { const int wc = Gp >> 3, idx = Gp & 7; return idx == 0 ? wc : idx == 4 ? 4 + wc : 8 + 6 * wc + (idx < 4 ? idx - 1 : idx - 2); }
constexpr size_t SLAB = 16 * MiB; constexpr size_t SLAB_EL = SLAB / 2;
constexpr size_t BB_Q = WS_BIG, BB_Y = WS_BIG + 9 * SLAB;
constexpr size_t BB_Q8 = WS_BIG + 3 * SLAB, BB_K8 = BB_Q8 + 24 * MiB, SLAB8 = 8 * MiB;

__device__ __forceinline__ void b_convert_weights(const Frame& F, const float* w_in, const float* ngain, const float* w_out, const float* qgain_, const float* kgain_, bool live = true) {
    LAS float* scr = (LAS float*)(F.lds + F.wave * 16384);
    const int gw = F.vcu * NWAVES + F.wave, NGW = F.G * NWAVES;
    constexpr int I_IN = (D / 64) * (BIN / 32), I_OUT = (D / 64) * (D / 32);
    bf16* WqT = (bf16*)(F.ws + WB_QKZ); bf16* WvT = (bf16*)(F.ws + WB_V); bf16* WoT = (bf16*)(F.ws + WB_OUT);
    for (int it = gw; it < I_IN + I_OUT; it += NGW) {
        if (it < I_IN) {
            const int nb = it % (BIN / 32), kb = it / (BIN / 32), ns = 32 * nb;
            const int seg = ns >> 10, w = ns & 1023;
            if (seg < 6) { const int g = seg >> 1, t = seg & 1, hd = w >> 7, p = (w & 127) + 4 * (F.lane & 7);
                transpose_item<true>(w_in, BIN, D, ngain, WqT, 0, ns, 64 * kb, scr, F.lane, live, t * 3072 + g * 1024 + hd * 128 + 4 * pi4(p >> 2)); }
            else if (seg < 9) transpose_item<true>(w_in, BIN, D, ngain, WvT, ns, (seg - 6) * 1024 + w, 64 * kb, scr, F.lane, live);
            else transpose_item<true>(w_in, BIN, D, ngain, WqT, ns, 6144 + w, 64 * kb, scr, F.lane, live);
        } else {
            const int r = it - I_IN, nb = r % (D / 32), kb = r / (D / 32);
            transpose_item(w_out, D, D, nullptr, WoT, 32 * nb, 32 * nb, 64 * kb, scr, F.lane, live);
        }
    }
    { float* gp = (float*)(F.ws + WS_GP); for (int i = F.vcu * 512 + F.tid; i < 768; i += F.G * 512) { const int sl = i >> 7, p = i & 127; const float* src = (sl < 3 ? qgain_ : kgain_) + (sl % 3) * 128; const float v_ = src[4 * pi4(p >> 2) + (p & 3)]; if (live) gp[i] = v_; } }
    float* rope = (float*)(F.ws + WS_ROPE);
    for (int i = F.vcu * 512 + F.tid; i < SEQ * 16; i += F.G * 512) {
        const int pos = i >> 4, fi = i & 15;
        const float inv_freq = powf(500000.0f, -(float)fi / 16.0f);
        const float ang = (float)pos * inv_freq;
        const float cs_ = (float)cos((double)ang), sn_ = (float)sin((double)ang); if (live) { rope[2 * i] = cs_; rope[2 * i + 1] = sn_; }
    }
}

struct SchedB1 {
    pg8::TileOrder T; unsigned XBb;
    __device__ __forceinline__ bool next(int i, pg8::Unit& u) const {
        const bool dry_ = false; if (!T.tile(i, u.pm, u.pn)) return false; u.bswz = 0;
        u.rsa = XB8P; u.rsb = D;
        if (u.pn < 28) { u.a = XBb + (unsigned)u.pm * 256u * XB8P; u.b = (unsigned)WB_QKZ + (unsigned)u.pn * 256u * D; u.kind = (u.pn < 24) ? 0 : 1; }
        else { const int idx = u.pn - 28, g = idx >> 2, ct = idx & 3, sh = 2 * g, n0 = u.pm * 256, L = SEQ >> sh, r = n0 >> (13 - sh), l0 = n0 & (L - 1);
               u.a = (unsigned)WB_V + (unsigned)(g * 1024 + 256 * ct) * D; u.b = XBb + (unsigned)((l0 << sh) + r) * XB8P; u.rsa = D; u.rsb = XB8P << sh; u.kind = 2; u.bswz = 1; }
        if (dry_) u.kind = 99;
        return true;
    }
};
__device__ __forceinline__ float rx8_of(const LAS float* xl, int i) { return rx_of(xl, i) * F8_WINV; }
struct EpiB1 {
    static constexpr bool PERM = true;
    bf16* S0; bf16* ZSb; const float* XSSb; const float* gperm; const float* rope; bool live;
    __device__ __forceinline__ void prefetch(const pg8::Unit& u, LAS unsigned char* lds, int par, int w) const {
        const int kind_ = u.kind & 15;
        if (kind_ < 2) xss_prefetch256(XSSb + (size_t)u.pm * 256 * 4, lds, par, w);
        else if (kind_ == 2) {
            const int idx = u.pn - 28, g = idx >> 2, sh = 2 * g, n0 = u.pm * 256, L = SEQ >> sh, r = n0 >> (13 - sh), l0 = n0 & (L - 1), tok0 = (l0 << sh) + r;
            int cc = 64 * w + lane_id(); cc ^= (((cc >> 2) ^ (cc >> 3)) & 1) * 12;
            __builtin_amdgcn_global_load_lds((const unsigned*)(XSSb + (size_t)(tok0 + (cc << sh)) * 4), (LAS unsigned*)(lds + RXL_OFF + par * 4096 + w * 1024), 16, 0, 0);
        }
    }
    __device__ __forceinline__ void operator()(const f32x4 (&acc)[2][2][4][2], const pg8::Unit& u, int wr, int wc, int fr, int fq, LAS unsigned char* lds, int par) const {
        const LAS float* XL = (const LAS float*)(lds + RXL_OFF + par * 4096);
        const int kind_ = u.kind;
        asm volatile("" : "+v"(fr), "+v"(fq));
        if (kind_ == 0) {
            const int seg = u.pn >> 2, g = seg >> 1, isk = seg & 1, ct = u.pn & 3;
            unsigned char* dst = (unsigned char*)S0 + (BB_Q8 - WS_BIG) + (size_t)(isk * 3 + g) * SLAB8;
            const float* gain = gperm + (isk * 3 + g) * 128 + wc * 32 + 8 * fq;
            LAS float* T = (LAS float*)(lds + XCH_OFF);
            float rxs[8];
            const f32x4 g0 = *(const f32x4*)(gain), g1 = *(const f32x4*)(gain + 4);
            f32x4 cs[2][2];
            { const f32x4* rp = (const f32x4*)(rope + ((size_t)(u.pm * 256 + wr * 64 + fr) * 16 + 4 * wc) * 2); cs[0][0] = rp[0]; cs[0][1] = rp[1]; }
#pragma unroll
            for (int ai = 0; ai < 2; ++ai)
#pragma unroll
                for (int m = 0; m < 4; ++m) {
                    const int rl = ai * 128 + wr * 64 + m * 16 + fr; const float rx = rx8_of(XL, rl); rxs[ai * 4 + m] = rx;
#pragma unroll
                    for (int bj = 0; bj < 2; ++bj) {
                        const f32x4 v0 = acc[ai][bj][m][0], v1 = acc[ai][bj][m][1];
                        float s = (v0[0] * v0[0] + v0[1] * v0[1]) + (v0[2] * v0[2] + v0[3] * v0[3]) + (v1[0] * v1[0] + v1[1] * v1[1]) + (v1[2] * v1[2] + v1[3] * v1[3]);
                        s = sum_x32(sum_x16(s)) * (rx * rx);
                        if (fq == 0) T[(rl * 2 + bj) * 4 + wc] = s;
                    }
                }
            LDS_WAIT(); __builtin_amdgcn_s_barrier(); asm volatile("" : "+v"(fr), "+v"(fq) :: "memory");
            const float* rp0 = rope + ((size_t)(u.pm * 256 + wr * 64 + fr) * 16 + 4 * wc) * 2;
#define QK_ROPE_LOAD(k_) do { const f32x4* rp = (const f32x4*)(rp0 + (size_t)((((k_) >> 2) * 128 + ((k_) & 3) * 16) * 32)); cs[(k_) & 1][0] = rp[0]; cs[(k_) & 1][1] = rp[1]; } while (0)
#pragma unroll
            for (int k = 0; k < 8; ++k) {
                const int ai = k >> 2, m = k & 3;
                const int rl = ai * 128 + wr * 64 + m * 16 + fr, pos = u.pm * 256 + rl; const float rx = rxs[k];
                if (k < 7) QK_ROPE_LOAD(k + 1);
                const f32x4 c0 = cs[k & 1][0], c1 = cs[k & 1][1];
                const bool lo = fq < 2, isr = (fq & 1) == 0;
#pragma unroll
                for (int bj = 0; bj < 2; ++bj) {
                    const f32x4 t4 = *(const LAS f32x4*)(T + (rl * 2 + bj) * 4);
                    const float rh = rx * __builtin_amdgcn_rsqf(((t4[0] + t4[1]) + (t4[2] + t4[3])) * (1.f / 128.f) + EPS);
                    f32x4 v0 = acc[ai][bj][m][0] * rh * g0, v1 = acc[ai][bj][m][1] * rh * g1;
                    f32x4 o0;
#pragma unroll
                    for (int e = 0; e < 4; ++e) o0[e] = get_x32(v0[e], lo);
                    const float sg = lo ? -1.f : 1.f;
                    const float r0 = v0[0] * c0[0] + sg * o0[0] * c0[1], r1 = v0[1] * c0[2] + sg * o0[1] * c0[3], r2 = v0[2] * c1[0] + sg * o0[2] * c1[1], r3 = v0[3] * c1[2] + sg * o0[3] * c1[3];
                    if (isr) { v0[0] = r0; v0[1] = r1; v0[2] = r2; v0[3] = r3; }
                    u32x2 w; w.x = pk8(v0[0], v0[1], v0[2], v0[3]); w.y = pk8(v1[0], v1[1], v1[2], v1[3]);
                    if (live) *(u32x2*)(dst + (size_t)pos * 1024 + (2 * ct + bj) * 128 + wc * 32 + 8 * fq) = w;
                }
            }
#undef QK_ROPE_LOAD
        } else if (kind_ == 1) {
            bf16* dst = ZSb;
            const int col0 = (u.pn - 24) * 256 + wc * 32 + 8 * fq;
#pragma unroll
            for (int ai = 0; ai < 2; ++ai)
#pragma unroll
                for (int m = 0; m < 4; ++m) {
                    const int pos = u.pm * 256 + ai * 128 + wr * 64 + m * 16 + fr; const float rx = rx8_of(XL, ai * 128 + wr * 64 + m * 16 + fr);
#pragma unroll
                    for (int bj = 0; bj < 2; ++bj) {
                        f32x4 v0 = acc[ai][bj][m][0] * rx, v1 = acc[ai][bj][m][1] * rx;
#pragma unroll
                        for (int e = 0; e < 4; ++e) { v0[e] = silu_f(v0[e]); v1[e] = silu_f(v1[e]); }
                        u32x4 w; w.x = cvtpk(v0[0], v0[1]); w.y = cvtpk(v0[2], v0[3]); w.z = cvtpk(v1[0], v1[1]); w.w = cvtpk(v1[2], v1[3]);
                        if (live) *(u32x4*)(dst + (size_t)pos * 1024 + col0 + bj * 128) = w;
                    }
                }
        } else if (kind_ == 2) {
            const int idx = u.pn - 28, g = idx >> 2, ct = idx & 3, sh = 2 * g, n0 = u.pm * 256, L = SEQ >> sh, r = n0 >> (13 - sh), l0 = n0 & (L - 1);
            bf16* dst = S0 + (size_t)(6 + g) * SLAB_EL; (void)r; (void)l0;
            const int cbase = wc * 32 + 8 * fq;
#pragma unroll
            for (int bj = 0; bj < 2; ++bj) {
                const int c_ = bj * 128 + cbase; const f32x4 rx0 = (f32x4){rx8_of(XL, c_), rx8_of(XL, c_ + 1), rx8_of(XL, c_ + 2), rx8_of(XL, c_ + 3)}, rx1 = (f32x4){rx8_of(XL, c_ + 4), rx8_of(XL, c_ + 5), rx8_of(XL, c_ + 6), rx8_of(XL, c_ + 7)};
#pragma unroll
                for (int ai = 0; ai < 2; ++ai)
#pragma unroll
                    for (int m = 0; m < 4; ++m) {
                        const int ch = 256 * ct + ai * 128 + wr * 64 + m * 16 + fr;
                        const f32x4 v0 = acc[ai][bj][m][0] * rx0, v1 = acc[ai][bj][m][1] * rx1;
                        u32x4 w; w.x = cvtpk(v0[0], v0[1]); w.y = cvtpk(v0[2], v0[3]); w.z = cvtpk(v1[0], v1[1]); w.w = cvtpk(v1[2], v1[3]);
                        if (live) *(u32x4*)(dst + (size_t)ch * SEQ + n0 + bj * 128 + cbase) = w;
                    }
            }
        }
    }
};

__device__ __forceinline__ int crow16(int reg, int hh) { return (reg & 3) + 8 * (reg >> 2) + 4 * hh; }

constexpr int ATT_KL = 0, ATT_KS = 136, ATT_VL = 256 * 136, ATT_VS = 528, ATT_OL = ATT_VL + 128 * 528, ATT_OS = 272;
static_assert(ATT_OL + 128 * ATT_OS <= MISC_OFF, "attention LDS map");
__device__ __forceinline__ void att_decode(int wu, int& g, int& h, int& sh, int& L, int& r, int& l0) {
    const int blk = wu & 63, hg = wu >> 6; h = hg & 7; g = hg >> 3; sh = 2 * g; L = SEQ >> sh; const int n0 = blk * 128; r = n0 >> (13 - sh); l0 = n0 & (L - 1);
}
__device__ __forceinline__ void b_attn_phase(const Frame& F, bool live = true) {
    bf16* S0 = (bf16*)(F.ws + WS_BIG); float* LSE = (float*)(F.ws + WS_LSE);
    const unsigned char* Q8 = F.ws + BB_Q8; const unsigned char* K8 = F.ws + BB_K8;
    LAS unsigned char* kl = F.lds + ATT_KL; LAS unsigned char* vl = F.lds + ATT_VL; LAS unsigned char* ol = F.lds + ATT_OL;
    const int r32 = F.lane & 31, hh = F.lane >> 5, qb = F.wave >> 1, half = F.wave & 1;
    constexpr int NU = 3 * 8 * 64;
    const int per = (NU + F.G - 1) / F.G, u0 = F.vcu * per, u1 = (u0 + per < NU) ? u0 + per : NU;
    u32x4 kch[4], vch[8];
#define ATT_LOAD(wu_, cont_) do { int g_, h_, sh_, L_, r_, l0_; att_decode(wu_, g_, h_, sh_, L_, r_, l0_); const int t_ = F.wave * 64 + lane_id(); \
        const unsigned char* Ks_ = K8 + (size_t)g_ * SLAB8 + h_ * 128 + (t_ & 7) * 16; \
        const bf16* Vs_ = S0 + (size_t)(6 + g_) * SLAB_EL + (size_t)(h_ * 128 + (t_ >> 4)) * SEQ + r_ * L_ + (t_ & 15) * 8; const int pa_ = l0_ < 128 ? 0 : l0_ - 128; \
        _Pragma("unroll") for (int k = 0; k < 2; ++k) { if (!(cont_)) { const int lk_ = l0_ - 128 + (t_ >> 3) + 64 * k, lkc_ = lk_ < 0 ? 0 : lk_; kch[k] = *(const u32x4*)(Ks_ + (size_t)((lkc_ << sh_) + r_) * 1024); } \
            kch[2 + k] = *(const u32x4*)(Ks_ + (size_t)(((l0_ + (t_ >> 3) + 64 * k) << sh_) + r_) * 1024); } \
        _Pragma("unroll") for (int k = 0; k < 4; ++k) { if (!(cont_)) vch[k] = *(const u32x4*)(Vs_ + (size_t)(32 * k) * SEQ + pa_); \
            vch[4 + k] = *(const u32x4*)(Vs_ + (size_t)(32 * k) * SEQ + l0_); } } while (0)
    int par = 0; bool cont = false;
    u32x4 qq[4];
#define ATT_LOAD_Q(wu_) do { int g_, h_, sh_, L_, r_, l0_; att_decode(wu_, g_, h_, sh_, L_, r_, l0_); \
        const unsigned char* q_ = Q8 + (size_t)g_ * SLAB8 + (size_t)(((l0_ + 32 * qb + r32) << sh_) + r_) * 1024 + h_ * 128 + 64 * hh; \
        _Pragma("unroll") for (int s = 0; s < 4; ++s) qq[s] = *(const u32x4*)(q_ + 16 * s); } while (0)
    if (u0 < u1) { ATT_LOAD(u0, false); ATT_LOAD_Q(u0); }
    for (int wu = u0; wu < u1; ++wu) {
        int g, h, sh, L, r, l0; att_decode(wu, g, h, sh, L, r, l0);
        bf16* Os = S0 + (size_t)g * SLAB_EL;
        const int tl = F.wave * 64 + lane_id();
        { LAS unsigned char* ks = kl + (tl >> 3) * ATT_KS + (tl & 7) * 16; LAS unsigned char* vs = vl + (tl >> 4) * ATT_VS + (tl & 15) * 16;
#pragma unroll
          for (int k = 0; k < 2; ++k) {
            if (!cont) { LAS unsigned char* d_ = ks + (par * 128 + 64 * k) * ATT_KS; *(LAS u32x2*)(d_) = (u32x2){kch[k].x, kch[k].y}; *(LAS u32x2*)(d_ + 8) = (u32x2){kch[k].z, kch[k].w}; }
            { LAS unsigned char* d_ = ks + ((par ^ 1) * 128 + 64 * k) * ATT_KS; *(LAS u32x2*)(d_) = (u32x2){kch[2 + k].x, kch[2 + k].y}; *(LAS u32x2*)(d_ + 8) = (u32x2){kch[2 + k].z, kch[2 + k].w}; } }
#pragma unroll
          for (int k = 0; k < 4; ++k) {
            if (!cont) *(LAS u32x4*)(vs + 32 * k * ATT_VS + par * 256) = vch[k];
            *(LAS u32x4*)(vs + 32 * k * ATT_VS + (par ^ 1) * 256) = vch[4 + k]; } }
        __syncthreads();
        bool ncont = false;
        if (wu + 1 < u1) { int g_, h_, sh_, L_, r_, l0n; att_decode(wu + 1, g_, h_, sh_, L_, r_, l0n); ncont = (l0n != 0); if (ncont) ATT_LOAD(wu + 1, true); else ATT_LOAD(wu + 1, false); }
        const int lq = l0 + 32 * qb + r32, tq = (lq << sh) + r;
        f32x16 sc[5];
#pragma unroll
        for (int t = 0; t < 5; ++t) {
            const int w0 = 32 * (qb + t);
            const LAS unsigned char* kp = kl + ((par ^ (w0 >> 7)) * 128 + (w0 & 127) + r32) * ATT_KS + 64 * hh;
            f32x16 a;
#pragma unroll
            for (int i = 0; i < 16; ++i) a[i] = 0.f;
#pragma unroll
            for (int s = 0; s < 8; ++s) { const u32x2 kf = *(const LAS u32x2*)(kp + 8 * s);
                const unsigned qlo = (s & 1) ? qq[s >> 1].z : qq[s >> 1].x, qhi = (s & 1) ? qq[s >> 1].w : qq[s >> 1].y;
                a = __builtin_amdgcn_mfma_f32_32x32x16_fp8_fp8((long)(((unsigned long)kf.y << 32) | kf.x), (long)(((unsigned long)qhi << 32) | qlo), a, 0, 0, 0); }
            sc[t] = a;
        }
        const int lb = l0 + 32 * qb;
        float mx = -INFINITY;
#pragma unroll
        for (int t = 0; t < 5; ++t) {
            const bool tile_ok = (lb - 128 + 32 * t) >= 0;
#pragma unroll
            for (int i = 0; i < 16; ++i) {
                bool ok = tile_ok;
                if (t == 0) ok = ok && (crow16(i, hh) >= r32);
                if (t == 4) ok = ok && (crow16(i, hh) <= r32);
                const float v = (t == 0 || t == 4 || !tile_ok) ? (ok ? sc[t][i] : -INFINITY) : sc[t][i]; sc[t][i] = v; mx = fmaxf(mx, v);
            }
        }
        mx = max_x32(mx);
        const float k2 = 0.08838834764831845f * 1.4426950408889634f;
        float lsum = 0.f; const float nmk = -mx * k2;
#pragma unroll
        for (int t = 0; t < 5; ++t)
#pragma unroll
            for (int i = 0; i < 16; ++i) { const float p = __builtin_amdgcn_exp2f(__builtin_fmaf(sc[t][i], k2, nmk)); sc[t][i] = p; lsum += p; }
        lsum = sum_x32(lsum);
        __builtin_amdgcn_sched_barrier(0);
        if (wu + 1 < u1) ATT_LOAD_Q(wu + 1);
        f32x16 o[2];
#pragma unroll
        for (int d2 = 0; d2 < 2; ++d2)
#pragma unroll
            for (int i = 0; i < 16; ++i) o[d2][i] = 0.f;
        const LAS unsigned char* vp = vl + (64 * half + r32) * ATT_VS + 16 * hh;
#pragma unroll
        for (int t = 0; t < 5; ++t) {
            const int w0 = 32 * (qb + t);
            const LAS unsigned char* vpt = vp + (par ^ (w0 >> 7)) * 256 + (w0 & 127) * 2;
#pragma unroll
            for (int s2 = 0; s2 < 2; ++s2) {
                u32x4 pw; pw.x = cvtpk(sc[t][8 * s2 + 0], sc[t][8 * s2 + 1]); pw.y = cvtpk(sc[t][8 * s2 + 2], sc[t][8 * s2 + 3]);
                pw.z = cvtpk(sc[t][8 * s2 + 4], sc[t][8 * s2 + 5]); pw.w = cvtpk(sc[t][8 * s2 + 6], sc[t][8 * s2 + 7]);
                const bf16x8 pf = __builtin_bit_cast(bf16x8, pw);
#pragma unroll
                for (int d2 = 0; d2 < 2; ++d2)
                    o[d2] = __builtin_amdgcn_mfma_f32_32x32x16_bf16(*(const LAS bf16x8*)(vpt + d2 * 32 * ATT_VS + 32 * s2), pf, o[d2], 0, 0, 0);
            }
        }
        const float inv = __builtin_amdgcn_rcpf(lsum);
        if (half == 0 && hh == 0 && live) LSE[((size_t)g * SEQ + tq) * 8 + h] = mx * 0.08838834764831845f + __logf(lsum);
#pragma unroll
        for (int d2 = 0; d2 < 2; ++d2)
#pragma unroll
            for (int q4 = 0; q4 < 4; ++q4) {
                u32x2 w; w.x = cvtpk(o[d2][4 * q4 + 0] * inv, o[d2][4 * q4 + 1] * inv); w.y = cvtpk(o[d2][4 * q4 + 2] * inv, o[d2][4 * q4 + 3] * inv);
                *(LAS u32x2*)(ol + (32 * qb + r32) * ATT_OS + (64 * half + 32 * d2 + 8 * q4 + 4 * hh) * 2) = w;
            }
        __syncthreads();
#pragma unroll
        for (int k = 0; k < 4; ++k) {
            const int row = (tl >> 4) + 32 * k;
            const u32x4 w = *(const LAS u32x4*)(ol + row * ATT_OS + (tl & 15) * 16);
            if (live) *(u32x4*)(Os + (size_t)(((l0 + row) << sh) + r) * 1024 + h * 128 + (tl & 15) * 8) = w;
        }
        cont = ncont; if (ncont) par ^= 1;
    }
    __syncthreads();
#undef ATT_LOAD
#undef ATT_LOAD_Q
}
__device__ __forceinline__ void b_combine_phase(const Frame& F, int b, int wi, int nw, bool live = true) {
    const bf16* S0 = (const bf16*)(F.ws + WS_BIG); const float* LSE = (const float*)(F.ws + WS_LSE); bf16* Y = (bf16*)(F.ws + BB_Y) + (size_t)b * SEQ * 1024;
    struct Item { u32x4 o0, o1, o2, zz; float e0, e1, e2; size_t off; };
    const int stride = nw * 512;
    int i = wi * 512 + F.tid;
#define CMB_LOAD(it_, i_) do { const int tok = (i_) >> 7, c = ((i_) & 127) * 8, h = c >> 7; \
        it_.e0 = LSE[((size_t)0 * SEQ + tok) * 8 + h]; it_.e1 = LSE[((size_t)1 * SEQ + tok) * 8 + h]; it_.e2 = LSE[((size_t)2 * SEQ + tok) * 8 + h]; it_.off = (size_t)tok * 1024 + c; \
        it_.o0 = *(const u32x4*)(S0 + it_.off); it_.o1 = *(const u32x4*)(S0 + SLAB_EL + it_.off); it_.o2 = *(const u32x4*)(S0 + 2 * SLAB_EL + it_.off); it_.zz = *(const u32x4*)(Y + it_.off); } while (0)
    Item cur, nxt;
    if (i < SEQ * 128) CMB_LOAD(cur, i);
    for (; i < SEQ * 128; i += stride) {
        const bool more = i + stride < SEQ * 128;
        if (more) CMB_LOAD(nxt, i + stride);
        const float mx = fmaxf(cur.e0, fmaxf(cur.e1, cur.e2));
        float w0 = __expf(cur.e0 - mx), w1 = __expf(cur.e1 - mx), w2 = __expf(cur.e2 - mx);
        const float inv = __builtin_amdgcn_rcpf(w0 + w1 + w2); w0 *= inv; w1 *= inv; w2 *= inv;
        u32x4 y;
#define CMB(w) cvtpk((w0 * bf_lo(cur.o0.w) + w1 * bf_lo(cur.o1.w) + w2 * bf_lo(cur.o2.w)) * bf_lo(cur.zz.w), (w0 * bf_hi(cur.o0.w) + w1 * bf_hi(cur.o1.w) + w2 * bf_hi(cur.o2.w)) * bf_hi(cur.zz.w))
        y.x = CMB(x); y.y = CMB(y); y.z = CMB(z); y.w = CMB(w);
#undef CMB
        if (live) *(u32x4*)(Y + cur.off) = y;
        if (more) cur = nxt;
    }
#undef CMB_LOAD
}

__global__ void __launch_bounds__(NWAVES * 64, 2) mk_fwd(Args args) {
    extern __shared__ __attribute__((aligned(16))) unsigned char lds_raw[];
    Frame F;
    F.lds = (LAS unsigned char*)lds_raw;
    F.tid = threadIdx.x; F.lane = F.tid & 63; F.wave = __builtin_amdgcn_readfirstlane(F.tid >> 6);
    F.G = gridDim.x; { const int bx = blockIdx.x; F.vcu = (F.G % 8 == 0) ? (bx % 8) * (F.G / 8) + bx / 8 : bx; }
    F.ws = args.ws;
    volatile LAS unsigned* MISC = (volatile LAS unsigned*)(F.lds + MISC_OFF);
    for (int u = F.tid; u < (LDS_BYTES - LDSCTL_OFF) / 4; u += NWAVES * 64) ((LAS unsigned*)(F.lds + LDSCTL_OFF))[u] = 0u;
    __syncthreads();
    XcdBarrier bar = xcd_barrier_post((unsigned*)(F.ws + WS_CTL) + CW_BAR, MISC + 8);
#define GRID_BAR() xcd_barrier(bar, F.wave)
#define LOCAL_BAR() do { if (xcd_even) xcd_local_barrier(bar, F.wave); else xcd_barrier(bar, F.wave); } while (0)
#define FRESH_IDS() int mo_ = MISC_OFF + 40; asm volatile("" : "+s"(mo_)); const volatile LAS unsigned* mp_ = (const volatile LAS unsigned*)(F.lds + mo_); const unsigned xi_ = mp_[1]; const bool xcd_even = __builtin_amdgcn_readfirstlane((int)(xi_ >> 8)) != 0; int bx_ = xcd_even ? __builtin_amdgcn_readfirstlane((int)(mp_[0] * 8u + (xi_ & 255u))) : (int)blockIdx.x; asm volatile("" : "+s"(bx_)); (void)xcd_even;     F.vcu = (F.G % 8 == 0) ? (bx_ % 8) * (F.G / 8) + bx_ / 8 : bx_; F.lane = lane_id(); F.tid = F.wave * 64 + F.lane
    { FRESH_IDS(); (void)bx_;
      { bf16* XR = (bf16*)(F.ws + WS_XB); float* XSS = (float*)(F.ws + WS_XSS); const int gw = F.vcu * NWAVES + F.wave, NGW = F.G * NWAVES;
        for (int m = 2 * gw; m < M; m += 2 * NGW) x_rows_prep2(args.in[0] + (size_t)m * D, XR + (size_t)m * XBP, XSS + (size_t)m * 4, F.lane); }
      a_convert_weights(F, args.in[2], args.in[1], args.in[6], args.in[4]);
      GRID_BAR();
      }
#pragma unroll
    for (int layer = 0; layer < 4; ++layer) {
        const int kind = layer % 3;
        FRESH_IDS();
        const int is_last = (layer == 3);
        if (kind == 0) {
            { SchedA1 S; S.init(F.G, bx_); S.XB = (unsigned)WS_XB; S.W = (unsigned)WA_IN;
              EpiA1 E{(bf16*)(F.ws + BA_G), (bf16*)(F.ws + BA_VT), (const float*)(F.ws + WS_XSS), (float*)(F.ws + WS_VSS), true, (const bf16*)(F.ws + WS_WM), args.in[5] + (size_t)(layer / 3) * 8 * 128, args.in[3] + (size_t)(layer / 3) * AW, &bar, xcd_even};
              pg8::gemm_phase<EpiA1, SchedA1, true>(F.lds, F.ws, D, S, E, F.wave);
              if (!S.has_uz()) LOCAL_BAR(); }
            LOCAL_BAR();
            if (layer == 0) { b_convert_weights(F, args.in[7], args.in[1] + (size_t)1 * D, args.in[10], args.in[8], args.in[9]); __syncthreads(); }
            { SchedOut S; S.T.init(M / 256, D / 256, F.G, bx_); S.Y = (unsigned)BA_G; S.W = (unsigned)WA_OUT; S.kbytes = AW * 2;
              EpiOut E{(layer == 0) ? args.in[0] : (const float*)nullptr, (bf16*)(F.ws + WS_XB), (float*)(F.ws + WS_XSS), is_last ? args.out : (float*)nullptr, true, (layer == 0) ? F.ws + WS_XB8 : (unsigned char*)nullptr};
              pg8::gemm_phase<EpiOut, SchedOut, true>(F.lds, F.ws, AW, S, E, F.wave); }
            if (!is_last) GRID_BAR();
        }
        if (kind == 1) {
#pragma unroll 1
            for (int b = 0; b < BATCH; ++b) {
                { SchedB1 S; S.T.init(SEQ / 256, 40, F.G, bx_); S.XBb = (unsigned)WS_XB8 + (unsigned)b * (unsigned)SEQ * XB8P;
                  EpiB1 E{(bf16*)(F.ws + WS_BIG), (bf16*)(F.ws + BB_Y) + (size_t)b * SEQ * 1024, (const float*)(F.ws + WS_XSS) + (size_t)b * SEQ * 4, (const float*)(F.ws + WS_GP), (const float*)(F.ws + WS_ROPE), true};
                  pg8::gemm_phase<EpiB1, SchedB1, true, true>(F.lds, F.ws, D / 2, S, E, F.wave); }
                GRID_BAR();
                { F.lane = lane_id(); F.tid = F.wave * 64 + F.lane; }
                b_attn_phase(F);
                if (b == 1) c_convert_fold_inputs(F, args.in[11], args.in[1] + (size_t)2 * D, args.in[12]);
                GRID_BAR();
                if (b == 0) b_combine_phase(F, b, F.vcu, F.G);
                else if (bx_ < 32) { SchedFold S{F.G, bx_}; EpiPlainBf16 E{(bf16*)(F.ws + WC_IN), D, true, true};
                    pg8::gemm_phase<EpiPlainBf16, SchedFold, true>(F.lds, F.ws, 512, S, E, F.wave); }
                else { b_combine_phase(F, b, bx_ - 32, F.G - 32); c_convert_rest(F, args.in[11], args.in[1] + (size_t)2 * D, args.in[14], bx_ - 32, F.G - 32); }
                if (b == 1) GRID_BAR();
            }
            { SchedOut S; S.T.init(M / 256, D / 256, F.G, bx_); S.Y = (unsigned)BB_Y; S.W = (unsigned)WB_OUT; S.kbytes = D * 2;
              EpiOut E{(const float*)nullptr, (bf16*)(F.ws + WS_XB), (float*)(F.ws + WS_XSS), (float*)nullptr, true, (unsigned char*)nullptr};
              pg8::gemm_phase<EpiOut, SchedOut, true>(F.lds, F.ws, D, S, E, F.wave); }
            LOCAL_BAR();
        }
        if (kind == 2) {
            { SchedC1 S; S.T.init(M / 256, CIN / 256, F.G, bx_);
              EpiC1 E{(bf16*)(F.ws + BC_X), (bf16*)(F.ws + BC_Z), (const float*)(F.ws + WS_XSS), args.in[13], true};
              pg8::gemm_phase<EpiC1, SchedC1, true>(F.lds, F.ws, D, S, E, F.wave); }
            GRID_BAR();
            c_pool_phase(F, args.in[13]);
            a_convert_weights(F, args.in[2] + (size_t)1 * D * AIN, args.in[1] + (size_t)3 * D, args.in[6] + (size_t)1 * AW * D, args.in[4] + (size_t)1 * 8 * 128 * 128);
            GRID_BAR();
            { SchedOut S; S.T.init(M / 256, D / 256, F.G, bx_); S.Y = (unsigned)BC_Z; S.W = (unsigned)WC_OUT; S.kbytes = CW * 2;
              EpiOut E{(const float*)nullptr, (bf16*)(F.ws + WS_XB), (float*)(F.ws + WS_XSS), (float*)nullptr, true, (unsigned char*)nullptr};
              pg8::gemm_phase<EpiOut, SchedOut, true>(F.lds, F.ws, CW, S, E, F.wave); }
            LOCAL_BAR();
        }
    }
}

static int g_grid = 0, g_coop = 1;
static void mk_launch(void* const* d_in, void* d_out, void* d_ws, hipStream_t stream) {
    if (g_grid == 0) {
        int dev = 0, cus = 0, per_cu = 0;
        (void)hipGetDevice(&dev);
        (void)hipDeviceGetAttribute(&cus, hipDeviceAttributeMultiprocessorCount, dev);
        (void)hipFuncSetAttribute((const void*)mk_fwd, hipFuncAttributeMaxDynamicSharedMemorySize, LDS_BYTES);
        if (hipOccupancyMaxActiveBlocksPerMultiprocessor(&per_cu, (const void*)mk_fwd, NWAVES * 64, LDS_BYTES) != hipSuccess) per_cu = 0;
        (void)hipGetLastError();
        if (per_cu < 1) fprintf(stderr, "kernel_launch: occupancy query reports %d blocks per CU for %d B of LDS\n", per_cu, LDS_BYTES);
        g_grid = (cus > 0 ? cus : 256);
    }
    (void)hipMemsetAsync((char*)d_ws + WS_CTL, 0, CTL_ZERO_BYTES, stream);
    Args a{};
    for (int i = 0; i < 15; ++i) a.in[i] = (const float*)d_in[i];
    a.out = (float*)d_out; a.ws = (unsigned char*)d_ws;
    void* params[] = {&a};
    hipError_t e = hipErrorUnknown;
    if (g_coop) {
        e = hipLaunchCooperativeKernel((const void*)mk_fwd, dim3(g_grid), dim3(NWAVES * 64), params, LDS_BYTES, stream);
        if (e != hipSuccess) { fprintf(stderr, "cooperative launch failed: %s; falling back to a plain launch\n", hipGetErrorString(e)); (void)hipGetLastError(); g_coop = 0; }
    }
    if (!g_coop) hipLaunchKernelGGL(mk_fwd, dim3(g_grid), dim3(NWAVES * 64), LDS_BYTES, stream, a);
}

extern "C" void kernel_launch(void* const* d_in, const int* in_sizes, int n_in, void* d_out, int out_size, void* d_ws, size_t ws_size, hipStream_t stream) {
    if (n_in != 15 || out_size != M * D || ws_size < WS_END) { fprintf(stderr, "kernel_launch: unexpected sizes (n_in %d out %d ws %zu)\n", n_in, out_size, ws_size); return; }
    mk_launch(d_in, d_out, d_ws, stream);
}
```

```cpp
#include <hip/hip_runtime.h>
#include <cstdio>
#include <cstdint>

#define LAS __attribute__((address_space(3)))
#define GAS __attribute__((address_space(1)))
typedef unsigned short bf16;
typedef short bf16x8 __attribute__((ext_vector_type(8)));
typedef float f32x4 __attribute__((ext_vector_type(4)));
typedef float f32x16 __attribute__((ext_vector_type(16)));
typedef unsigned u32x4 __attribute__((ext_vector_type(4)));
typedef unsigned u32x2 __attribute__((ext_vector_type(2)));
typedef float f32x2_t __attribute__((ext_vector_type(2)));
typedef __bf16 bf16x2_t __attribute__((ext_vector_type(2)));
typedef int i32x4 __attribute__((ext_vector_type(4)));
typedef int i32x8 __attribute__((ext_vector_type(8)));

constexpr int D = 1024, BATCH = 2, SEQ = 8192, M = BATCH * SEQ;
constexpr float EPS = 1e-6f;
constexpr int AW = 2048, AIN = 3 * AW;
constexpr int BIN = 10240;
constexpr int CW = 2048, CIN = 2 * CW;

__device__ __forceinline__ unsigned cvtpk(float lo, float hi) { f32x2_t v = {lo, hi}; bf16x2_t b = __builtin_convertvector(v, bf16x2_t); return __builtin_bit_cast(unsigned, b); }
__device__ __forceinline__ unsigned pk8(float a, float b, float c, float d) { int w = __builtin_amdgcn_cvt_pk_fp8_f32(a, b, 0, false); w = __builtin_amdgcn_cvt_pk_fp8_f32(c, d, w, true); return (unsigned)w; }
__device__ __forceinline__ float bf_lo(unsigned w) { return __uint_as_float(w << 16); }
__device__ __forceinline__ float bf_hi(unsigned w) { return __uint_as_float(w & 0xffff0000u); }
__device__ __forceinline__ float silu_f(float z) { return z * __builtin_amdgcn_rcpf(1.f + __builtin_amdgcn_exp2f(-1.4426950408889634f * z)); }
__device__ __forceinline__ float sum_x32(float v) { const auto r = __builtin_amdgcn_permlane32_swap(__float_as_uint(v), __float_as_uint(v), false, false); return __uint_as_float(r[0]) + __uint_as_float(r[1]); }
__device__ __forceinline__ float sum_x16(float v) { const auto r = __builtin_amdgcn_permlane16_swap(__float_as_uint(v), __float_as_uint(v), false, false); return __uint_as_float(r[0]) + __uint_as_float(r[1]); }
__device__ __forceinline__ float get_x32(float v, bool lower_half) { const auto r = __builtin_amdgcn_permlane32_swap(__float_as_uint(v), __float_as_uint(v), false, false); return __uint_as_float(lower_half ? r[1] : r[0]); }
template <int CTRL> __device__ __forceinline__ float dpp_f(float v) { return __int_as_float(__builtin_amdgcn_update_dpp(0, __float_as_int(v), CTRL, 0xf, 0xf, true)); }
template <int S> __device__ __forceinline__ float dpp_ror(float v) { return __int_as_float(__builtin_amdgcn_update_dpp(0, __float_as_int(v), 0x120 + S, 0xf, 0xf, true)); }
template <int S> __device__ __forceinline__ float dpp_shr_old(float old, float v) { return __int_as_float(__builtin_amdgcn_update_dpp(__float_as_int(old), __float_as_int(v), 0x110 + S, 0xf, 0xf, false)); }
__device__ __forceinline__ float row16_sum(float v) { v += dpp_f<0x128>(v); v += dpp_f<0x124>(v); v += dpp_f<0x122>(v); v += dpp_f<0x121>(v); return v; }
__device__ __forceinline__ int lane_id() { int l; asm volatile("v_mbcnt_lo_u32_b32 %0, -1, 0\n\tv_mbcnt_hi_u32_b32 %0, -1, %0" : "=v"(l)); return l; }
__device__ __forceinline__ float max_x32(float v) { const auto r = __builtin_amdgcn_permlane32_swap(__float_as_uint(v), __float_as_uint(v), false, false); return fmaxf(__uint_as_float(r[0]), __uint_as_float(r[1])); }
__device__ __forceinline__ float wave_sum(float v) { return sum_x32(sum_x16(row16_sum(v))); }
#define LDS_WAIT() asm volatile("s_waitcnt lgkmcnt(0)" ::: "memory")
#define VM_WAIT() asm volatile("s_waitcnt vmcnt(0)" ::: "memory")

namespace pg8 {
constexpr int BM = 256, BK = 64, HALF = 128, HTB = HALF * BK * 2  , STAGE_BYTES = 8 * HTB, NXCD = 8, WGM = 4;
__host__ __device__ __forceinline__ int lds_byte(int r, int c) { const int st = (r >> 4) * 2 + (c >> 5), rr = r & 15, cc = c & 31, ob = rr * 64 + cc * 2; return st * 1024 + (ob ^ (((ob >> 9) & 1) << 5)); }
__host__ __device__ __forceinline__ void stage_rc(int b, int& R, int& C) { const int st = b / 1024, sb = b % 1024, swz = sb ^ (((sb >> 9) & 1) << 5); R = (st >> 1) * 16 + swz / 64; C = (st & 1) * 32 + (swz % 64) / 2; }
__host__ __device__ __forceinline__ int perm32(int rho) { const int n = rho >> 4, i = rho & 15; return 8 * (i >> 2) + 4 * n + (i & 3); }

struct Unit { int pm, pn, kind; unsigned rsa, rsb, a, b, bswz; };

struct TileOrder {
    int nM, nN, nwg, G, c;
    __device__ void init(int nM_, int nN_, int G_, int c_) { nM = nM_; nN = nN_; nwg = nM * nN; G = G_; c = c_; }
    __device__ bool tile(int i, int& pm, int& pn) const {
        const long L = (long)i * G + c; if (L >= nwg) return false;
        int wgid = (int)L; { const int q = nwg / NXCD, r = nwg % NXCD, xcd = wgid % NXCD, off = wgid / NXCD; wgid = (xcd < r ? xcd * (q + 1) : r * (q + 1) + (xcd - r) * q) + off; }
        const int nig = WGM * nN, gid = wgid / nig, fm = gid * WGM, gsz = (nM - fm) < WGM ? (nM - fm) : WGM;
        pm = fm + ((wgid % nig) % gsz); pn = (wgid % nig) / gsz; return true;
    }
};

template <class Epi, class Sched, bool ALIGN_EPI, bool F8 = false>
__device__ __forceinline__ void gemm_phase(LAS unsigned char* lds, const unsigned char* wsb, const int K, const Sched& S, const Epi& E, const int wave) {
    int wid = wave; asm volatile("" : "+s"(wid));
    const int tid = wid * 64 + lane_id();
    const int lane = tid & 63, wr = wid >> 2, wc = wid & 3, fr = lane & 15, fq = lane >> 4;
    const int nt = K / BK;
#define PG8_VOFF(vA, vB, rsa_, rsb_, bswz_) do { const int tid_ = wid * 64 + lane_id(); _Pragma("unroll") for (int _i = 0; _i < 2; ++_i) { int R_, C_; stage_rc(tid_ * 16 + _i * 8192, R_, C_); \
        int Rb_ = Epi::PERM ? ((R_ & ~31) + perm32(R_ & 31)) : R_; if (bswz_) Rb_ ^= (((Rb_ >> 2) ^ (Rb_ >> 3)) & 1) * 12; vA[_i] = (unsigned)R_ * (rsa_) + (unsigned)C_ * 2u; vB[_i] = (unsigned)Rb_ * (rsb_) + (unsigned)C_ * 2u; } } while (0)
    const unsigned kstep = (unsigned)(BK * 2);
    const unsigned ldsw = (unsigned)wid * 1024u;
    const int aoff = lds_byte(wr * 64 + fr, fq * 8), boff = lds_byte(wc * 32 + fr, fq * 8);
#define PG8_SA(b, h) (((b) * 2 + (h)) * HTB)
#define PG8_SB(b, h) ((4 + (b) * 2 + (h)) * HTB)
#define PG8_STAGE(bufoff, gbase, voff) do { _Pragma("unroll") for (int _i = 0; _i < 2; ++_i) \
        __builtin_amdgcn_global_load_lds((const unsigned*)(wsb + (size_t)((gbase) + (voff)[_i])), (LAS unsigned*)(lds + (bufoff) + ldsw + _i * 8192), 16, 0, 0); } while (0)
#define PG8_LDA(dst, b, h) do { _Pragma("unroll") for (int m = 0; m < 4; ++m) _Pragma("unroll") for (int k = 0; k < 2; ++k) dst[m][k] = *(const LAS bf16x8*)(lds + PG8_SA(b, h) + aoff + m * 2048 + k * 1024); } while (0)
#define PG8_LDB(dst, b, h) do { _Pragma("unroll") for (int n = 0; n < 2; ++n) _Pragma("unroll") for (int k = 0; k < 2; ++k) dst[n][k] = *(const LAS bf16x8*)(lds + PG8_SB(b, h) + boff + n * 2048 + k * 1024); } while (0)
#define PG8_CAT8(x_) __builtin_shufflevector(__builtin_bit_cast(i32x4, x_[0]), __builtin_bit_cast(i32x4, x_[1]), 0, 1, 2, 3, 4, 5, 6, 7)
#define PG8_MMA(ai, bj, At, Bt) do { __builtin_amdgcn_s_setprio(1); _Pragma("unroll") for (int m = 0; m < 4; ++m) _Pragma("unroll") for (int n = 0; n < 2; ++n) { \
        if constexpr (F8) acc[ai][bj][m][n] = __builtin_amdgcn_mfma_scale_f32_16x16x128_f8f6f4(PG8_CAT8(Bt[n]), PG8_CAT8(At[m]), acc[ai][bj][m][n], 0, 0, 0, 0, 0, 0); \
        else { _Pragma("unroll") for (int k = 0; k < 2; ++k) acc[ai][bj][m][n] = __builtin_amdgcn_mfma_f32_16x16x32_bf16(Bt[n][k], At[m][k], acc[ai][bj][m][n], 0, 0, 0); } } __builtin_amdgcn_s_setprio(0); } while (0)
#define PG8_WAIT_V(n) asm volatile("s_waitcnt vmcnt(" #n ")" ::: "memory")
#define PG8_WAIT_L(n) asm volatile("s_waitcnt lgkmcnt(" #n ")" ::: "memory")
#define PG8_BAR __builtin_amdgcn_s_barrier()
#define PG8_SCHED __builtin_amdgcn_sched_barrier(0)
    Unit cur, nxt; int ui = 0;
    if (!S.next(0, cur)) return;
    f32x4 acc[2][2][4][2];
#pragma unroll
    for (int a = 0; a < 2; ++a)
#pragma unroll
        for (int b = 0; b < 2; ++b)
#pragma unroll
            for (int m = 0; m < 4; ++m)
#pragma unroll
                for (int n = 0; n < 2; ++n) acc[a][b][m][n] = (f32x4){0.f, 0.f, 0.f, 0.f};
    bf16x8 At[4][2], B0[2][2], B1[2][2];
    unsigned cA = cur.a, cB = cur.b;
    unsigned chA = HALF * cur.rsa, chB = HALF * cur.rsb;
    unsigned cvA[2], cvB[2];
    PG8_VOFF(cvA, cvB, cur.rsa, cur.rsb, cur.bswz);
    if (wid < 4) E.prefetch(cur, lds, 0, wid);
    PG8_STAGE(PG8_SB(0, 0), cB, cvB); PG8_STAGE(PG8_SB(0, 1), cB + chB, cvB); PG8_STAGE(PG8_SA(0, 0), cA, cvA); PG8_STAGE(PG8_SA(0, 1), cA + chA, cvA);
    if (wr == 1) PG8_BAR;
    PG8_WAIT_V(2); PG8_BAR;
    PG8_STAGE(PG8_SB(1, 0), cB + kstep, cvB); PG8_STAGE(PG8_SA(1, 0), cA + kstep, cvA); PG8_STAGE(PG8_SB(1, 1), cB + chB + kstep, cvB);
    PG8_WAIT_V(6); PG8_BAR;
    for (;;) {
        const bool has_next = S.next(ui + 1, nxt);
        const unsigned nA = has_next ? nxt.a : cA, nB = has_next ? nxt.b : cB;
        const unsigned nrsa = has_next ? nxt.rsa : cur.rsa, nrsb = has_next ? nxt.rsb : cur.rsb, nbswz = has_next ? nxt.bswz : cur.bswz;
        const unsigned nhA = HALF * nrsa, nhB = HALF * nrsb;
        for (int t = 0; t < nt; t += 2) {
            const bool last = (t == nt - 2);
            const unsigned a1 = cA + (unsigned)(t + 1) * kstep;
            const unsigned a2 = last ? nA : cA + (unsigned)(t + 2) * kstep, b2 = last ? nB : cB + (unsigned)(t + 2) * kstep;
            const unsigned a3 = a2 + kstep, b3 = b2 + kstep;
            const unsigned hA2 = last ? nhA : chA, hB2 = last ? nhB : chB;
            unsigned vA2[2], vB2[2];
            if (last) { PG8_VOFF(vA2, vB2, nrsa, nrsb, nbswz); } else { vA2[0] = cvA[0]; vA2[1] = cvA[1]; vB2[0] = cvB[0]; vB2[1] = cvB[1]; }
            PG8_LDB(B0, 0, 0); PG8_LDB(B1, 0, 1); PG8_SCHED; PG8_LDA(At, 0, 0); PG8_STAGE(PG8_SA(1, 1), a1 + chA, cvA);
            PG8_WAIT_V(8); PG8_WAIT_L(0); PG8_BAR; PG8_MMA(0, 0, At, B0); PG8_MMA(0, 1, At, B1); PG8_BAR; PG8_SCHED;
            PG8_LDA(At, 0, 1); PG8_STAGE(PG8_SB(0, 0), b2, vB2); PG8_STAGE(PG8_SB(0, 1), b2 + hB2, vB2); PG8_STAGE(PG8_SA(0, 0), a2, vA2);
            PG8_WAIT_V(8); PG8_WAIT_L(0); PG8_BAR; PG8_MMA(1, 0, At, B0); PG8_MMA(1, 1, At, B1); PG8_BAR; PG8_SCHED;
            PG8_LDB(B0, 1, 0); PG8_LDB(B1, 1, 1); PG8_SCHED; PG8_LDA(At, 1, 0); PG8_STAGE(PG8_SA(0, 1), a2 + hA2, vA2);
            PG8_WAIT_V(8); PG8_WAIT_L(0); PG8_BAR; PG8_MMA(0, 0, At, B0); PG8_MMA(0, 1, At, B1); PG8_BAR; PG8_SCHED;
            PG8_LDA(At, 1, 1); PG8_STAGE(PG8_SB(1, 0), b3, vB2); PG8_STAGE(PG8_SB(1, 1), b3 + hB2, vB2); PG8_STAGE(PG8_SA(1, 0), a3, vA2);
            PG8_WAIT_V(8); PG8_WAIT_L(0); PG8_BAR; PG8_MMA(1, 0, At, B0); PG8_MMA(1, 1, At, B1); PG8_BAR; PG8_SCHED;
        }
        if constexpr (ALIGN_EPI) { if (wr == 0) PG8_BAR; }
        { const int te_ = lane_id(); E(acc, cur, wr, wc, te_ & 15, te_ >> 4, lds, ui & 1); }
        if (!has_next) break;
#pragma unroll
        for (int a = 0; a < 2; ++a)
#pragma unroll
            for (int b = 0; b < 2; ++b)
#pragma unroll
                for (int m = 0; m < 4; ++m)
#pragma unroll
                    for (int n = 0; n < 2; ++n) acc[a][b][m][n] = (f32x4){0.f, 0.f, 0.f, 0.f};
        cur = nxt; cA = nA; cB = nB; chA = nhA; chB = nhB; ++ui;
        PG8_VOFF(cvA, cvB, cur.rsa, cur.rsb, cur.bswz);
        if (wid < 4) E.prefetch(cur, lds, ui & 1, wid);
        if constexpr (ALIGN_EPI) { if (wr == 1) PG8_BAR; }
    }
    PG8_WAIT_V(0);
    if constexpr (!ALIGN_EPI) { if (wr == 0) PG8_BAR; }
    PG8_BAR;
#undef PG8_VOFF
#undef PG8_SA
#undef PG8_SB
#undef PG8_STAGE
#undef PG8_LDA
#undef PG8_LDB
#undef PG8_MMA
#undef PG8_CAT8
#undef PG8_WAIT_V
#undef PG8_WAIT_L
#undef PG8_BAR
#undef PG8_SCHED
}
}

constexpr size_t MiB = 1u << 20;
constexpr size_t WS_CTL = 0, CTL_ZERO_BYTES = 64 * 1024;
constexpr size_t WS_ROPE = 1 * MiB;
constexpr size_t WS_XSS = 3 * MiB;
constexpr size_t WS_VSS = 4 * MiB;
constexpr size_t WS_LSE = 5 * MiB;
constexpr size_t WS_WM = 5 * MiB + 768 * 1024;
constexpr size_t WS_W = 8 * MiB;
constexpr size_t WS_XB = 30 * MiB;
constexpr unsigned XBP = D + 64, XBPB = XBP * 2;
constexpr size_t WS_XB8 = 8 * MiB;
constexpr unsigned XB8P = D + 128;
constexpr size_t WS_BIG = 64 * MiB;
constexpr size_t WS_END = 256 * MiB;
constexpr int CW_BAR = 1024;

constexpr int RING_BYTES = 131072;
constexpr int LDSCTL_OFF = RING_BYTES, MISC_OFF = 151552 - 256;
constexpr int XCH_OFF = LDSCTL_OFF;
constexpr int RXL_OFF = XCH_OFF + 8192;
constexpr int LDS_BYTES = 151552;
constexpr int NWAVES = 8;

typedef GAS unsigned gu32;
#define RLX_AGENT __ATOMIC_RELAXED, __HIP_MEMORY_SCOPE_AGENT

#define XB_TMO      128
#define XB_XCNT(j)  (256  + 64 * (j))
#define XB_XSUB(j)  (1280 + 64 * (j))
#define XB_XGEN(j)  (2304 + 64 * (j))
#define XB_TOP      3328
#define XB_TOPGEN   3392
#define XB_XLOC(j)  (3456 + 64 * (j))
#define XCD_BAR_WORDS 4480
#define XB_SPIN_CAP (1u << 18)

__device__ __forceinline__ unsigned xb_ld(unsigned* p)              { return __hip_atomic_load(p, __ATOMIC_RELAXED, __HIP_MEMORY_SCOPE_AGENT); }
__device__ __forceinline__ unsigned xb_add(unsigned* p, unsigned v) { return __hip_atomic_fetch_add(p, v, __ATOMIC_RELAXED, __HIP_MEMORY_SCOPE_AGENT); }
__device__ __forceinline__ unsigned xb_xcc_id() { return (unsigned)__builtin_amdgcn_s_getreg((3 << 11) | 20) & 0xFu; }
#define XB_SPIN(cond, bar) do { unsigned _sp = 0; while (cond) { __builtin_amdgcn_s_sleep(1); \
    if ((++_sp & 255u) == 0u) { if (xb_ld(&(bar)[XB_TMO])) break; if (_sp > XB_SPIN_CAP) { atomicAdd(&(bar)[XB_TMO], 1u); break; } } } } while (0)

struct XcdBarrier {
    unsigned* bar; unsigned x;
    volatile LAS unsigned* st;
};

__device__ __forceinline__ XcdBarrier xcd_barrier_post(unsigned* bar, volatile LAS unsigned* st) {
    XcdBarrier b; b.bar = bar; b.x = xb_xcc_id(); b.st = st;
    if (threadIdx.x == 0) st[2] = xb_add(&bar[XB_XCNT(b.x)], 1u);
    return b;
}
__device__ __forceinline__ void xcd_barrier_complete(unsigned* bar, unsigned x, unsigned& nloc, unsigned& nx, unsigned& xinfo) {
    const unsigned G = gridDim.x * gridDim.y * gridDim.z;
    unsigned sum, cnt, mine, sp = 0u;
    for (;;) {
        sum = 0u; cnt = 0u; mine = 0u;
#pragma unroll
        for (unsigned j = 0; j < 16; ++j) { const unsigned c = xb_ld(&bar[XB_XCNT(j)]); sum += c; cnt += (c > 0u) ? 1u : 0u; mine = (j == x) ? c : mine; }
        if (sum == G) break;
        __builtin_amdgcn_s_sleep(1);
        if ((++sp & 255u) == 0u) { if (xb_ld(&bar[XB_TMO])) break; if (sp > XB_SPIN_CAP) { atomicAdd(&bar[XB_TMO], 1u); break; } }
    }
    nloc = mine > 0u ? mine : 1u; nx = cnt > 0u ? cnt : 1u;
    unsigned below = 0u, uneq = 0u;
#pragma unroll
    for (unsigned j = 0; j < 16; ++j) { const unsigned c = xb_ld(&bar[XB_XCNT(j)]); below += (c > 0u && j < x) ? 1u : 0u; uneq += (c > 0u && c != mine) ? 1u : 0u; }
    xinfo = below | ((uneq == 0u && sum == G && cnt == 8u && cnt * mine == G) ? 256u : 0u);
}

__device__ __forceinline__ void xcd_barrier(const XcdBarrier& b, const int wave) {
    asm volatile("s_waitcnt vmcnt(0)" ::: "memory");
    __syncthreads();
    if (wave == 1 && lane_id() == 0) {
        __builtin_amdgcn_fence(__ATOMIC_ACQUIRE, "agent");
        asm volatile("s_waitcnt vmcnt(0)" ::: "memory");
    }
    if (wave == 0 && lane_id() == 0) {
        unsigned* bar = b.bar;
        __builtin_amdgcn_s_waitcnt(0);
        unsigned nloc = b.st[0], nx = b.st[1];
        if (nloc == 0u) { unsigned xi_; xcd_barrier_complete(bar, b.x, nloc, nx, xi_); b.st[0] = nloc; b.st[1] = nx; b.st[3] = xi_; }
        const unsigned old = xb_add(&bar[XB_XSUB(b.x)], 1u);
        const unsigned gen = old / nloc;
        if (old + 1u == (gen + 1u) * nloc) {
            __builtin_amdgcn_fence(__ATOMIC_RELEASE, "agent");
            asm volatile("s_waitcnt vmcnt(0)" ::: "memory");
            const unsigned og = xb_add(&bar[XB_TOP], 1u);
            const unsigned tg = og / nx;
            if (og + 1u == (tg + 1u) * nx) {
#pragma unroll
                for (unsigned j = 0; j < 16; ++j) (void)xb_add(&bar[XB_XGEN(j)], 1u);
            }
        }
        XB_SPIN(xb_ld(&bar[XB_XGEN(b.x)]) == gen, bar);
        asm volatile("s_waitcnt vmcnt(0)" ::: "memory");
    }
    __syncthreads();
}

__device__ __forceinline__ void xcd_local_barrier(const XcdBarrier& b, const int wave) {
    asm volatile("s_waitcnt vmcnt(0)" ::: "memory");
    __syncthreads();
    if (wave == 1 && lane_id() == 0) {
        __builtin_amdgcn_fence(__ATOMIC_ACQUIRE, "agent");
        asm volatile("s_waitcnt vmcnt(0)" ::: "memory");
    }
    if (wave == 0 && lane_id() == 0) {
        unsigned* bar = b.bar;
        __builtin_amdgcn_s_waitcnt(0);
        const unsigned nloc = b.st[0];
        const unsigned old = xb_add(&bar[XB_XLOC(b.x)], 1u);
        const unsigned tgt = (old / nloc + 1u) * nloc;
        if (old + 1u != tgt) XB_SPIN(xb_ld(&bar[XB_XLOC(b.x)]) < tgt, bar);
        asm volatile("s_waitcnt vmcnt(0)" ::: "memory");
    }
    __syncthreads();
}


struct Args { const float* in[15]; float* out; unsigned char* ws; };
struct Frame {
    LAS unsigned char* lds;
    int tid, lane, wave, vcu, G;
    unsigned char* ws;
};

constexpr float F8_WMUL = 64.f, F8_WINV = 1.f / 64.f;
template <bool F8 = false>
__device__ __forceinline__ void transpose_item(const float* __restrict__ W, int ldw, int K, const float* __restrict__ gain, bf16* WT, int nsrc0, int ndst0, int k0, LAS float* scr, int lane, bool live = true, int src_lane_col = -1) {
    f32x4 v[8]; float gk[8];
    const int kr = lane >> 3, n4 = (lane & 7) * 4;
#pragma unroll
    for (int i = 0; i < 8; ++i) { v[i] = *(const f32x4*)(W + (size_t)(k0 + kr + 8 * i) * ldw + (src_lane_col >= 0 ? src_lane_col : nsrc0 + n4)); gk[i] = (gain ? gain[k0 + kr + 8 * i] : 1.f) * (F8 ? F8_WMUL : 1.f); }
#pragma unroll
    for (int i = 0; i < 8; ++i) { LAS float* d = scr + (kr + 8 * i) * 33 + n4; d[0] = v[i][0] * gk[i]; d[1] = v[i][1] * gk[i]; d[2] = v[i][2] * gk[i]; d[3] = v[i][3] * gk[i]; }
    LDS_WAIT(); asm volatile("" ::: "memory");
    const int c = lane & 7;
#pragma unroll
    for (int j = 0; j < 4; ++j) { const int n = (lane >> 3) + 8 * j; const LAS float* s = scr + (8 * c) * 33 + n;
        if constexpr (F8) { u32x2 o; o.x = pk8(s[0 * 33], s[1 * 33], s[2 * 33], s[3 * 33]); o.y = pk8(s[4 * 33], s[5 * 33], s[6 * 33], s[7 * 33]);
            if (live) *(u32x2*)((unsigned char*)WT + (size_t)(ndst0 + n) * K + k0 + 8 * c) = o; }
        else { u32x4 o; o.x = cvtpk(s[0 * 33], s[1 * 33]); o.y = cvtpk(s[2 * 33], s[3 * 33]); o.z = cvtpk(s[4 * 33], s[5 * 33]); o.w = cvtpk(s[6 * 33], s[7 * 33]);
            if (live) *(u32x4*)(WT + (size_t)(ndst0 + n) * K + k0 + 8 * c) = o; } }
    LDS_WAIT(); asm volatile("" ::: "memory");
}

__device__ __forceinline__ void x_rows_prep2(const float* xrow, bf16* orow, float* xss, int lane, bool live = true) {
    const f32x4* xr = (const f32x4*)xrow + lane;
    f32x4 v[2][4]; float s[2] = {0.f, 0.f};
#pragma unroll
    for (int r = 0; r < 2; ++r)
#pragma unroll
        for (int j = 0; j < 4; ++j) v[r][j] = xr[r * (D / 4) + 64 * j];
#pragma unroll
    for (int r = 0; r < 2; ++r) {
#pragma unroll
        for (int j = 0; j < 4; ++j) s[r] += (v[r][j].x * v[r][j].x + v[r][j].y * v[r][j].y) + (v[r][j].z * v[r][j].z + v[r][j].w * v[r][j].w);
        const float tot = wave_sum(s[r]);
        u32x2* o8 = (u32x2*)(orow + (size_t)r * XBP) + lane;
#pragma unroll
        for (int j = 0; j < 4; ++j) { u32x2 w; w.x = cvtpk(v[r][j].x, v[r][j].y); w.y = cvtpk(v[r][j].z, v[r][j].w); if (live) o8[64 * j] = w; }
        if (lane == 0 && live) *(f32x4*)(xss + 4 * r) = (f32x4){tot, 0.f, 0.f, 0.f};
    }
}

constexpr size_t WA_IN = 194 * MiB, WA_OUT = WA_IN + (size_t)AIN * D * 2;
constexpr size_t BA_G = WS_BIG, BA_VT = WS_BIG + (size_t)M * AW * 2;
constexpr int VTS = M + 64;

__device__ __forceinline__ void a_convert_weights(const Frame& F, const float* w_in, const float* ngain, const float* w_out, const float* w_s, bool live = true) {
    { bf16* Wm = (bf16*)(F.ws + WS_WM);
      for (int q = F.vcu * 512 + F.tid; q < 8 * 128 * 16; q += F.G * 512) { const int i = (q >> 4) & 127, j0 = (q & 15) * 8; const f32x4 a = *(const f32x4*)(w_s + (size_t)q * 8), b = *(const f32x4*)(w_s + (size_t)q * 8 + 4);
        u32x4 o; o.x = cvtpk(j0 + 0 <= i ? a[0] : 0.f, j0 + 1 <= i ? a[1] : 0.f); o.y = cvtpk(j0 + 2 <= i ? a[2] : 0.f, j0 + 3 <= i ? a[3] : 0.f);
        o.z = cvtpk(j0 + 4 <= i ? b[0] : 0.f, j0 + 5 <= i ? b[1] : 0.f); o.w = cvtpk(j0 + 6 <= i ? b[2] : 0.f, j0 + 7 <= i ? b[3] : 0.f); if (live) *(u32x4*)(Wm + (size_t)q * 8) = o; } }
    LAS float* scr = (LAS float*)(F.lds + F.wave * 16384);
    const int gw = F.vcu * NWAVES + F.wave, NGW = F.G * NWAVES;
    constexpr int I_IN = (D / 64) * (AIN / 32), I_OUT = (AW / 64) * (D / 32);
    bf16* WinT = (bf16*)(F.ws + WA_IN); bf16* WoT = (bf16*)(F.ws + WA_OUT);
    for (int it = gw; it < I_IN + I_OUT; it += NGW) {
        if (it < I_IN) {
            const int nb = it % (AIN / 32), kb = it / (AIN / 32), nd = 32 * nb;
            int ns;
            if (nd < 4096) { const int t = nd >> 8, w = nd & 255; ns = (w < 128) ? (128 * t + w) : (2 * AW + 128 * t + (w - 128)); }
            else ns = AW + (nd - 4096);
            transpose_item(w_in, AIN, D, ngain, WinT, ns, nd, 64 * kb, scr, F.lane, live);
        } else {
            const int r = it - I_IN, nb = r % (D / 32), kb = r / (D / 32);
            transpose_item(w_out, D, AW, nullptr, WoT, 32 * nb, 32 * nb, 64 * kb, scr, F.lane, live);
        }
    }
}

__device__ __forceinline__ void xss_prefetch256(const float* xss_row0, LAS unsigned char* lds, int par, int w) {
    const int l = lane_id();
    __builtin_amdgcn_global_load_lds((const unsigned*)(xss_row0 + (size_t)(64 * w + l) * 4), (LAS unsigned*)(lds + RXL_OFF + par * 4096 + w * 1024), 16, 0, 0);
}
__device__ __forceinline__ float rx_of(const LAS float* xl, int i) { const f32x4 p = *(const LAS f32x4*)(xl + 4 * i); return __builtin_amdgcn_rsqf(((p[0] + p[1]) + (p[2] + p[3])) * (1.f / D) + EPS); }
struct SchedA1 {
    pg8::TileOrder Tv, Tu; unsigned XB, W; int nv;
    __device__ __forceinline__ void init(int G, int c) { Tv.init(M / 256, 8, G, c); Tu.init(M / 256, 16, G, c); nv = (Tv.nwg - c + G - 1) / G; if (nv < 0) nv = 0; }
    __device__ __forceinline__ bool has_uz() const { return Tu.c < Tu.nwg; }
    __device__ __forceinline__ bool next(int i, pg8::Unit& u) const {
        u.bswz = 0;
        if (i < nv) { if (!Tv.tile(i, u.pm, u.pn)) return false; u.pn += 16; } else { if (!Tu.tile(i - nv, u.pm, u.pn)) return false; }
        const unsigned x = XB + (unsigned)u.pm * 256u * XBPB, w = W + (unsigned)u.pn * 256u * (D * 2);
        if (u.pn < 16) { u.a = x; u.b = w; u.rsa = XBPB; u.rsb = D * 2; u.kind = (i == nv) ? 2 : 0; } else { u.a = w; u.b = x; u.rsa = D * 2; u.rsb = XBPB; u.kind = 1; }
        return true;
    }
};
struct EpiA1 {
    static constexpr bool PERM = true;
    bf16* Gm; bf16* VT; const float* XSS; float* VSS; bool live; const bf16* Wm; const float* bs; const float* vgain; const XcdBarrier* gbar; bool bar_local;
    __device__ __forceinline__ void prefetch(const pg8::Unit& u, LAS unsigned char* lds, int par, int w) const { if (u.kind != 99) xss_prefetch256(XSS + (size_t)u.pm * 256 * 4, lds, par, w); }
    __device__ __forceinline__ void operator()(const f32x4 (&acc)[2][2][4][2], const pg8::Unit& u, int wr, int wc, int fr, int fq, LAS unsigned char* lds, int par) const {
        const LAS float* XL = (const LAS float*)(lds + RXL_OFF + par * 4096);
        asm volatile("" : "+v"(fr), "+v"(fq));
        if (u.kind == 2) { if (bar_local) xcd_local_barrier(*gbar, wr * 4 + wc); else xcd_barrier(*gbar, wr * 4 + wc); }
        if (u.kind == 0 || u.kind == 2) {
            const int row0 = u.pm * 256 + wr * 64 + fr, col0 = u.pn * 128 + wc * 32 + 8 * fq, g = u.pn >> 1;
            LAS float* T = (LAS float*)(lds + XCH_OFF);
            float pv[16];
            if (wr == 0) {
#pragma unroll
                for (int p = 0; p < 16; ++p) pv[p] = VSS[(size_t)p * M + u.pm * 256 + wc * 64 + fq * 16 + fr];
            }
            u32x4 vf[2][4][2];
            const bf16* vp = VT + (size_t)(u.pn * 128 + wc * 32 + 8 * (fr >> 2) + (fr & 3)) * VTS + u.pm * 256 + 8 * fq;
#define A1_VLOAD(ai_) do { _Pragma("unroll") for (int ks = 0; ks < 4; ++ks) _Pragma("unroll") for (int n = 0; n < 2; ++n) vf[ai_][ks][n] = *(const u32x4*)(vp + (size_t)(4 * n) * VTS + (ai_) * 128 + ks * 32); } while (0)
            A1_VLOAD(0);
            const f32x4 vg0 = *(const f32x4*)(vgain + col0), vg1 = *(const f32x4*)(vgain + col0 + 4);
            const bf16* wp = Wm + ((size_t)(g * 128 + wr * 64 + fr) * 128 + 8 * fq);
            float bsv[4];
            { const float* bp = bs + g * 128 + wr * 64 + fr;
#pragma unroll
              for (int m = 0; m < 4; ++m) bsv[m] = bp[16 * m]; }
            u32x4 wf[4][4];
#define A1_WLOAD(m_) do { _Pragma("unroll") for (int ks = 0; ks < 4; ++ks) if (ks <= 2 * wr + ((m_) >> 1)) wf[m_][ks] = *(const u32x4*)(wp + (size_t)(16 * (m_)) * 128 + 32 * ks); } while (0)
            u32x2 gv[2][4][2];
#pragma unroll
            for (int ai = 0; ai < 2; ++ai)
#pragma unroll
                for (int m = 0; m < 4; ++m) {
                    const float rx = rx_of(XL, ai * 128 + wr * 64 + m * 16 + fr);
#pragma unroll
                    for (int n = 0; n < 2; ++n) { float g_[4];
#pragma unroll
                        for (int e = 0; e < 4; ++e) g_[e] = (acc[ai][0][m][n][e] * rx) * silu_f(acc[ai][1][m][n][e] * rx);
                        unsigned lo_ = cvtpk(g_[0], g_[1]), hi_ = cvtpk(g_[2], g_[3]); asm volatile("" : "+v"(lo_), "+v"(hi_));
                        gv[ai][m][n] = (u32x2){lo_, hi_}; }
                }
            __builtin_amdgcn_sched_barrier(0);
            A1_VLOAD(1);
            A1_WLOAD(0); A1_WLOAD(1); A1_WLOAD(2); A1_WLOAD(3);
            if (wr == 0) { float s_ = 0.f;
#pragma unroll
                for (int p = 0; p < 16; ++p) s_ += pv[p];
                T[wc * 64 + fq * 16 + fr] = __builtin_amdgcn_rsqf(s_ * (1.f / AW) + EPS); }
            LDS_WAIT(); __builtin_amdgcn_s_barrier(); asm volatile("" : "+v"(fr), "+v"(fq) :: "memory");
#pragma unroll
            for (int ai = 0; ai < 2; ++ai) {
#pragma unroll
                for (int ks = 0; ks < 4; ++ks) {
                    const f32x4 r0 = *(const LAS f32x4*)(T + ai * 128 + ks * 32 + 8 * fq), r1 = *(const LAS f32x4*)(T + ai * 128 + ks * 32 + 8 * fq + 4);
#pragma unroll
                    for (int n = 0; n < 2; ++n) { const u32x4 w_ = vf[ai][ks][n]; u32x4 o_;
                        o_.x = cvtpk(bf_lo(w_.x) * r0[0], bf_hi(w_.x) * r0[1]); o_.y = cvtpk(bf_lo(w_.y) * r0[2], bf_hi(w_.y) * r0[3]);
                        o_.z = cvtpk(bf_lo(w_.z) * r1[0], bf_hi(w_.z) * r1[1]); o_.w = cvtpk(bf_lo(w_.w) * r1[2], bf_hi(w_.w) * r1[3]); vf[ai][ks][n] = o_; }
                }
#pragma unroll
                for (int m = 0; m < 4; ++m) {
                    f32x4 d0 = (f32x4){0.f, 0.f, 0.f, 0.f}, d1 = (f32x4){0.f, 0.f, 0.f, 0.f};
#pragma unroll
                    for (int ks = 0; ks < 4; ++ks) if (ks <= 2 * wr + (m >> 1)) {
                        const bf16x8 wb = __builtin_bit_cast(bf16x8, wf[m][ks]);
                        d0 = __builtin_amdgcn_mfma_f32_16x16x32_bf16(__builtin_bit_cast(bf16x8, vf[ai][ks][0]), wb, d0, 0, 0, 0);
                        d1 = __builtin_amdgcn_mfma_f32_16x16x32_bf16(__builtin_bit_cast(bf16x8, vf[ai][ks][1]), wb, d1, 0, 0, 0);
                    }
                    const u32x2 ga = gv[ai][m][0], gb = gv[ai][m][1];
                    const f32x4 y0 = (f32x4){bf_lo(ga.x), bf_hi(ga.x), bf_lo(ga.y), bf_hi(ga.y)} * (vg0 * d0 + bsv[m]), y1 = (f32x4){bf_lo(gb.x), bf_hi(gb.x), bf_lo(gb.y), bf_hi(gb.y)} * (vg1 * d1 + bsv[m]);
                    u32x4 w; w.x = cvtpk(y0[0], y0[1]); w.y = cvtpk(y0[2], y0[3]); w.z = cvtpk(y1[0], y1[1]); w.w = cvtpk(y1[2], y1[3]);
                    if (live) *(u32x4*)(Gm + (size_t)(row0 + ai * 128 + m * 16) * AW + col0) = w;
                }
            }
#undef A1_WLOAD
#undef A1_VLOAD
        } else if (u.kind == 1) {
            const int ch0 = (u.pn - 16) * 256 + wr * 64 + fr, t0 = u.pm * 256 + wc * 32 + 8 * fq;
            f32x4 rxv[2][2], ss[2][2];
#pragma unroll
            for (int bj = 0; bj < 2; ++bj)
#pragma unroll
                for (int n = 0; n < 2; ++n) { const int c_ = wc * 32 + 8 * fq + bj * 128 + 4 * n; rxv[bj][n] = (f32x4){rx_of(XL, c_), rx_of(XL, c_ + 1), rx_of(XL, c_ + 2), rx_of(XL, c_ + 3)}; ss[bj][n] = (f32x4){0.f, 0.f, 0.f, 0.f}; }
#pragma unroll
            for (int ai = 0; ai < 2; ++ai)
#pragma unroll
                for (int m = 0; m < 4; ++m) {
                    const int ch = ch0 + ai * 128 + m * 16;
#pragma unroll
                    for (int bj = 0; bj < 2; ++bj) {
                        const f32x4 v0 = acc[ai][bj][m][0] * rxv[bj][0], v1 = acc[ai][bj][m][1] * rxv[bj][1];
                        ss[bj][0] += v0 * v0; ss[bj][1] += v1 * v1;
                        u32x4 w; w.x = cvtpk(v0[0], v0[1]); w.y = cvtpk(v0[2], v0[3]); w.z = cvtpk(v1[0], v1[1]); w.w = cvtpk(v1[2], v1[3]);
                        if (live) *(u32x4*)(VT + (size_t)ch * VTS + t0 + bj * 128) = w;
                    }
                }
#pragma unroll
            for (int bj = 0; bj < 2; ++bj)
#pragma unroll
                for (int n = 0; n < 2; ++n)
#pragma unroll
                    for (int e = 0; e < 4; ++e) ss[bj][n][e] = row16_sum(ss[bj][n][e]);
            if (fr == 0 && live) {
                const int p = (u.pn - 16) * 2 + wr;
#pragma unroll
                for (int bj = 0; bj < 2; ++bj)
#pragma unroll
                    for (int n = 0; n < 2; ++n) *(f32x4*)(VSS + (size_t)p * M + t0 + bj * 128 + 4 * n) = ss[bj][n];
            }
        }
    }
};

struct SchedOut {
    pg8::TileOrder T; unsigned Y, W, kbytes;
    __device__ __forceinline__ bool next(int i, pg8::Unit& u) const {
        if (!T.tile(i, u.pm, u.pn)) return false; u.bswz = 0;
        u.a = Y + (unsigned)u.pm * 256u * kbytes; u.b = W + (unsigned)u.pn * 256u * kbytes; u.rsa = kbytes; u.rsb = kbytes; u.kind = 0; return true;
    }
};
struct EpiOut {
    static constexpr bool PERM = true;
    const float* xf32; bf16* XR; float* XSS; float* outf32; bool live; unsigned char* X8;
    __device__ __forceinline__ void prefetch(const pg8::Unit&, LAS unsigned char*, int, int) const {}
    __device__ __forceinline__ void operator()(const f32x4 (&acc)[2][2][4][2], const pg8::Unit& u, int wr, int wc, int fr, int fq, LAS unsigned char* lds, int) const {
        LAS float* T = (LAS float*)(lds + XCH_OFF);
        asm volatile("" : "+v"(fr), "+v"(fq));
        const int row0 = u.pm * 256 + wr * 64 + fr, col0 = u.pn * 256 + wc * 32 + 8 * fq;
        f32x4 pf[2][2][2]; u32x4 pb[2][2];
#define EO_ROW(k_) (row0 + ((k_) >> 2) * 128 + ((k_) & 3) * 16)
#define EO_LOAD(k_) do { const int r_ = EO_ROW(k_); _Pragma("unroll") for (int bj = 0; bj < 2; ++bj) { \
            if (xf32) { const f32x4* p_ = (const f32x4*)(xf32 + (size_t)r_ * D + col0 + bj * 128); pf[(k_) & 1][bj][0] = p_[0]; pf[(k_) & 1][bj][1] = p_[1]; } \
            else pb[(k_) & 1][bj] = *(const u32x4*)(XR + (size_t)r_ * XBP + col0 + bj * 128); } } while (0)
#define EO_STORE(k_) do { const int r_ = EO_ROW(k_); float s_ = 0.f; _Pragma("unroll") for (int bj = 0; bj < 2; ++bj) { f32x4 o0, o1; \
            if (xf32) { o0 = pf[(k_) & 1][bj][0]; o1 = pf[(k_) & 1][bj][1]; } \
            else { const u32x4 w_ = pb[(k_) & 1][bj]; o0 = (f32x4){bf_lo(w_.x), bf_hi(w_.x), bf_lo(w_.y), bf_hi(w_.y)}; o1 = (f32x4){bf_lo(w_.z), bf_hi(w_.z), bf_lo(w_.w), bf_hi(w_.w)}; } \
            o0 += acc[(k_) >> 2][bj][(k_) & 3][0]; o1 += acc[(k_) >> 2][bj][(k_) & 3][1]; \
            if (outf32) { if (live) { f32x4* q_ = (f32x4*)(outf32 + (size_t)r_ * D + col0 + bj * 128); q_[0] = o0; q_[1] = o1; } } \
            else { u32x4 w_; w_.x = cvtpk(o0[0], o0[1]); w_.y = cvtpk(o0[2], o0[3]); w_.z = cvtpk(o1[0], o1[1]); w_.w = cvtpk(o1[2], o1[3]); if (live) *(u32x4*)(XR + (size_t)r_ * XBP + col0 + bj * 128) = w_; \
                   if (X8) { u32x2 b_; b_.x = pk8(o0[0], o0[1], o0[2], o0[3]); b_.y = pk8(o1[0], o1[1], o1[2], o1[3]); if (live) *(u32x2*)(X8 + (size_t)r_ * XB8P + col0 + bj * 128) = b_; } \
                   s_ += ((o0[0] * o0[0] + o0[1] * o0[1]) + (o0[2] * o0[2] + o0[3] * o0[3])) + ((o1[0] * o1[0] + o1[1] * o1[1]) + (o1[2] * o1[2] + o1[3] * o1[3])); } } \
            if (!outf32) { s_ = sum_x32(sum_x16(s_)); if (fq == 0) T[(r_ - u.pm * 256) * 4 + wc] = s_; } } while (0)
        EO_LOAD(0); EO_LOAD(1);
#pragma unroll
        for (int k = 0; k < 8; ++k) { EO_STORE(k); if (k + 2 < 8) EO_LOAD(k + 2); }
        if (!outf32) {
            LDS_WAIT(); __builtin_amdgcn_s_barrier(); asm volatile("" ::: "memory");
            const int t_ = (wr * 4 + wc) * 64 + fq * 16 + fr;
            if (t_ < 256) { const f32x4 p = *(const LAS f32x4*)(T + 4 * t_); if (live) XSS[(size_t)(u.pm * 256 + t_) * 4 + u.pn] = (p[0] + p[1]) + (p[2] + p[3]); }
        }
#undef EO_ROW
#undef EO_LOAD
#undef EO_STORE
    }
};


constexpr size_t WC_IN = 240 * MiB, WC_OUT = 248 * MiB, WC_NAT = 252 * MiB, WC_GT = 6 * MiB;
constexpr size_t BC_X = WS_BIG, BC_Z = WS_BIG + (size_t)M * CW * 2;

__device__ __forceinline__ void c_convert_fold_inputs(const Frame& F, const float* w_in, const float* ngain, const float* w_grp, bool live = true) {
    LAS float* scr = (LAS float*)(F.lds + F.wave * 16384);
    const int gw = F.vcu * NWAVES + F.wave, NGW = F.G * NWAVES;
    constexpr int I_G = 4 * (512 / 64) * (512 / 32);
    bf16* WGT = (bf16*)(F.ws + WC_GT); bf16* WN = (bf16*)(F.ws + WC_NAT);
    for (int r = gw; r < I_G; r += NGW) { const int g = r >> 7, q = r & 127, nb = q & 15, kb = q >> 4;
        transpose_item(w_grp + (size_t)g * 512 * 512, 512, 512, nullptr, WGT + (size_t)g * 512 * 512, 32 * nb, 32 * nb, 64 * kb, scr, F.lane, live); }
    for (int i = F.vcu * 512 + F.tid; i < D * CW / 8; i += F.G * 512) {
        const int k = i >> 8, c = (i & 255) * 8; const float gk = ngain[k];
        const f32x4 a = *(const f32x4*)(w_in + (size_t)k * CIN + c), b = *(const f32x4*)(w_in + (size_t)k * CIN + c + 4);
        u32x4 o; o.x = cvtpk(a[0] * gk, a[1] * gk); o.y = cvtpk(a[2] * gk, a[3] * gk); o.z = cvtpk(b[0] * gk, b[1] * gk); o.w = cvtpk(b[2] * gk, b[3] * gk);
        if (live) *(u32x4*)(WN + (size_t)k * CW + c) = o;
    }
}
__device__ __forceinline__ void c_convert_rest(const Frame& F, const float* w_in, const float* ngain, const float* w_out, int wi, int nw, bool live = true) {
    LAS float* scr = (LAS float*)(F.lds + F.wave * 16384);
    constexpr int I_Z = (D / 64) * (CW / 32), I_OUT = (CW / 64) * (D / 32);
    bf16* WcT = (bf16*)(F.ws + WC_IN); bf16* WoT = (bf16*)(F.ws + WC_OUT);
    for (int it = wi * NWAVES + F.wave; it < I_Z + I_OUT; it += nw * NWAVES) {
        if (it < I_Z) { const int nb = it % (CW / 32), kb = it / (CW / 32), c0 = 32 * nb; transpose_item(w_in, CIN, D, ngain, WcT, CW + c0, 256 * (c0 >> 7) + 128 + (c0 & 127), 64 * kb, scr, F.lane, live); }
        else { const int r = it - I_Z, nb = r % (D / 32), kb = r / (D / 32); transpose_item(w_out, D, CW, nullptr, WoT, 32 * nb, 32 * nb, 64 * kb, scr, F.lane, live); }
    }
}
struct SchedFold {
    int G, c;
    __device__ __forceinline__ bool next(int i, pg8::Unit& u) const {
        const int L = i * G + c; if (L >= 32) return false;
        const int g = L >> 3, dt = (L >> 2) & 1, kt = L & 3;
        u.pm = g * 2 + dt; u.pn = kt; u.kind = 0; u.bswz = 0;
        u.a = (unsigned)WC_GT + (unsigned)((g * 512 + 256 * dt) * 512) * 2u; u.rsa = 1024;
        u.b = (unsigned)WC_NAT + (unsigned)(256 * kt * CW + g * 512) * 2u; u.rsb = CW * 2;
        return true;
    }
};
struct EpiPlainBf16 {
    static constexpr bool PERM = true;
    bf16* O; int ldc; bool live; bool pair_rows;
    __device__ __forceinline__ void prefetch(const pg8::Unit&, LAS unsigned char*, int, int) const {}
    __device__ __forceinline__ void operator()(const f32x4 (&acc)[2][2][4][2], const pg8::Unit& u, int wr, int wc, int fr, int fq, LAS unsigned char*, int) const {
        asm volatile("" : "+v"(fr), "+v"(fq));
        const int row0 = u.pm * 256 + wr * 64 + fr, col0 = u.pn * 256 + wc * 32 + 8 * fq;
#pragma unroll
        for (int ai = 0; ai < 2; ++ai)
#pragma unroll
            for (int m = 0; m < 4; ++m) {
                const int rr_ = row0 + ai * 128 + m * 16; bf16* rowp = O + (size_t)(pair_rows ? rr_ + (rr_ & ~127) : rr_) * ldc + col0;
#pragma unroll
                for (int bj = 0; bj < 2; ++bj) { const f32x4 v0 = acc[ai][bj][m][0], v1 = acc[ai][bj][m][1];
                    u32x4 w; w.x = cvtpk(v0[0], v0[1]); w.y = cvtpk(v0[2], v0[3]); w.z = cvtpk(v1[0], v1[1]); w.w = cvtpk(v1[2], v1[3]);
                    if (live) *(u32x4*)(rowp + bj * 128) = w; }
            }
    }
};
struct SchedC1 {
    pg8::TileOrder T;
    __device__ __forceinline__ bool next(int i, pg8::Unit& u) const {
        const bool dry_ = false; if (!T.tile(i, u.pm, u.pn)) return false; u.bswz = 0;
        u.a = (unsigned)WS_XB + (unsigned)u.pm * 256u * XBPB; u.b = (unsigned)WC_IN + (unsigned)u.pn * 256u * (D * 2); u.rsa = XBPB; u.rsb = D * 2; u.kind = 0;
        (void)dry_; return true;
    }
};
struct EpiC1 {
    static constexpr bool PERM = true;
    bf16* XC; bf16* ZS; const float* XSS; const float* scale; bool live;
    __device__ __forceinline__ void prefetch(const pg8::Unit& u, LAS unsigned char* lds, int par, int w) const { xss_prefetch256(XSS + (size_t)u.pm * 256 * 4, lds, par, w); }
    __device__ __forceinline__ void operator()(const f32x4 (&acc)[2][2][4][2], const pg8::Unit& u, int wr, int wc, int fr, int fq, LAS unsigned char* lds, int par) const {
        const LAS float* XL = (const LAS float*)(lds + RXL_OFF + par * 4096);
        asm volatile("" : "+v"(fr), "+v"(fq));
        const int row0 = u.pm * 256 + wr * 64 + fr, col0 = u.pn * 128 + wc * 32 + 8 * fq;
        const int lev = (u.pn >> 2) + 1;
        const float invw = __builtin_amdgcn_rcpf((float)(1 << lev));
        const f32x4 sc0 = *(const f32x4*)(scale + col0), sc1 = *(const f32x4*)(scale + col0 + 4);
#pragma unroll
        for (int ai = 0; ai < 2; ++ai) {
            f32x4 xs[4][2];
#pragma unroll
            for (int m = 0; m < 4; ++m) { const float rx = rx_of(XL, ai * 128 + wr * 64 + m * 16 + fr); xs[m][0] = acc[ai][0][m][0] * rx; xs[m][1] = acc[ai][0][m][1] * rx; }
#pragma unroll
            for (int m = 0; m < 4; ++m) {
                const int r = row0 + ai * 128 + m * 16; const float rx = rx_of(XL, ai * 128 + wr * 64 + m * 16 + fr);
                f32x4 z0 = acc[ai][1][m][0] * rx, z1 = acc[ai][1][m][1] * rx;
#pragma unroll
                for (int e = 0; e < 4; ++e) { z0[e] = silu_f(z0[e]); z1[e] = silu_f(z1[e]); }
                u32x4 w;
                if (m == 0 || m == 3) { w.x = cvtpk(xs[m][0][0], xs[m][0][1]); w.y = cvtpk(xs[m][0][2], xs[m][0][3]); w.z = cvtpk(xs[m][1][0], xs[m][1][1]); w.w = cvtpk(xs[m][1][2], xs[m][1][3]);
                    if (live) *(u32x4*)(XC + (size_t)r * CW + col0) = w; }
                if (m > 0) {
                    f32x4 y0, y1;
#pragma unroll
                    for (int hq = 0; hq < 2; ++hq)
#pragma unroll
                        for (int e = 0; e < 4; ++e) {
                            float wc_ = xs[m][hq][e], wp_ = xs[m - 1][hq][e];
#define POOL_LEVEL(S_) if (lev > (S_ == 1 ? 0 : S_ == 2 ? 1 : S_ == 4 ? 2 : 3)) { const float tp_ = dpp_ror<S_>(wp_); const float shc_ = dpp_shr_old<S_>(tp_, wc_); const float shp_ = dpp_f<0x110 + S_>(wp_); wc_ += shc_; wp_ += shp_; }
                            POOL_LEVEL(1) POOL_LEVEL(2) POOL_LEVEL(4) POOL_LEVEL(8)
#undef POOL_LEVEL
                            const float yy = (wc_ * invw - xs[m][hq][e]) * (hq ? sc1[e] : sc0[e]) * (hq ? z1[e] : z0[e]);
                            if (hq) y1[e] = yy; else y0[e] = yy;
                        }
                    w.x = cvtpk(y0[0], y0[1]); w.y = cvtpk(y0[2], y0[3]); w.z = cvtpk(y1[0], y1[1]); w.w = cvtpk(y1[2], y1[3]);
                } else { w.x = cvtpk(z0[0], z0[1]); w.y = cvtpk(z0[2], z0[3]); w.z = cvtpk(z1[0], z1[1]); w.w = cvtpk(z1[2], z1[3]); }
                if (live) *(u32x4*)(ZS + (size_t)r * CW + col0) = w;
            }
        }
    }
};
__device__ __forceinline__ void c_pool_phase(const Frame& F, const float* scale, bool live = true) {
    const bf16* XC = (const bf16*)(F.ws + BC_X); bf16* ZS = (bf16*)(F.ws + BC_Z);
    const int gw = F.vcu * NWAVES + F.wave, NGW = F.G * NWAVES;
    for (int wt = gw; wt < (M / 64) * 2 * 4; wt += NGW) {
        const int seg = wt >> 2, g = wt & 3, w = 2 << g, t0 = (seg >> 1) * 64 + (seg & 1) * 8, bstart = t0 & ~(SEQ - 1), c = g * 512 + F.lane * 8;
        const f32x4 sc0 = *(const f32x4*)(scale + c), sc1 = *(const f32x4*)(scale + c + 4);
        float s[8];
#pragma unroll
        for (int e = 0; e < 8; ++e) s[e] = 0.f;
        for (int j = 1; j <= w; ++j) { const int t = t0 - j; if (t >= bstart) { const u32x4 v = *(const u32x4*)(XC + (size_t)t * CW + c);
            s[0] += bf_lo(v.x); s[1] += bf_hi(v.x); s[2] += bf_lo(v.y); s[3] += bf_hi(v.y); s[4] += bf_lo(v.z); s[5] += bf_hi(v.z); s[6] += bf_lo(v.w); s[7] += bf_hi(v.w); } }
        for (int tb = t0; tb < t0 + 8; tb += 4) {
            u32x4 xv[4], zv[4], ov[4];
#pragma unroll
            for (int i = 0; i < 4; ++i) { const int t = tb + i; xv[i] = *(const u32x4*)(XC + (size_t)t * CW + c); zv[i] = *(const u32x4*)(ZS + (size_t)t * CW + c);
                const int to = (t - w >= bstart) ? t - w : t; ov[i] = *(const u32x4*)(XC + (size_t)to * CW + c); }
#pragma unroll
            for (int i = 0; i < 4; ++i) {
                const int t = tb + i; const u32x4 v = xv[i], zz = zv[i], o = ov[i];
                const float x[8] = {bf_lo(v.x), bf_hi(v.x), bf_lo(v.y), bf_hi(v.y), bf_lo(v.z), bf_hi(v.z), bf_lo(v.w), bf_hi(v.w)};
#pragma unroll
                for (int e = 0; e < 8; ++e) s[e] += x[e];
                if (t - w >= bstart) { s[0] -= bf_lo(o.x); s[1] -= bf_hi(o.x); s[2] -= bf_lo(o.y); s[3] -= bf_hi(o.y); s[4] -= bf_lo(o.z); s[5] -= bf_hi(o.z); s[6] -= bf_lo(o.w); s[7] -= bf_hi(o.w); }
                const int cnt = (t - bstart + 1 < w) ? (t - bstart + 1) : w; const float inv = __builtin_amdgcn_rcpf((float)cnt);
                const float z[8] = {bf_lo(zz.x), bf_hi(zz.x), bf_lo(zz.y), bf_hi(zz.y), bf_lo(zz.z), bf_hi(zz.z), bf_lo(zz.w), bf_hi(zz.w)};
                float y[8];
#pragma unroll
                for (int e = 0; e < 8; ++e) y[e] = (s[e] * inv - x[e]) * ((e < 4) ? sc0[e] : sc1[e - 4]) * z[e];
                u32x4 ow; ow.x = cvtpk(y[0], y[1]); ow.y = cvtpk(y[2], y[3]); ow.z = cvtpk(y[4], y[5]); ow.w = cvtpk(y[6], y[7]);
                if (live) *(u32x4*)(ZS + (size_t)t * CW + c) = ow;
            }
        }
    }
}

constexpr size_t WB_QKZ = 240 * MiB, WB_V = 247 * MiB, WB_OUT = WS_W + 20 * MiB;
constexpr size_t WS_GP = 96 * 1024;
__host__ __device__ __forceinline__ int pi4(int Gp) { const int wc = Gp >> 3, idx = Gp & 7; return idx == 0 ? wc : idx == 4 ? 4 + wc : 8 + 6 * wc + (idx < 4 ? idx - 1 : idx - 2); }
constexpr size_t SLAB = 16 * MiB; constexpr size_t SLAB_EL = SLAB / 2;
constexpr size_t BB_Q = WS_BIG, BB_Y = WS_BIG + 9 * SLAB;
constexpr size_t BB_Q8 = WS_BIG + 3 * SLAB, BB_K8 = BB_Q8 + 24 * MiB, SLAB8 = 8 * MiB;

__device__ __forceinline__ void b_convert_weights(const Frame& F, const float* w_in, const float* ngain, const float* w_out, const float* qgain_, const float* kgain_, bool live = true) {
    LAS float* scr = (LAS float*)(F.lds + F.wave * 16384);
    const int gw = F.vcu * NWAVES + F.wave, NGW = F.G * NWAVES;
    constexpr int I_IN = (D / 64) * (BIN / 32), I_OUT = (D / 64) * (D / 32);
    bf16* WqT = (bf16*)(F.ws + WB_QKZ); bf16* WvT = (bf16*)(F.ws + WB_V); bf16* WoT = (bf16*)(F.ws + WB_OUT);
    for (int it = gw; it < I_IN + I_OUT; it += NGW) {
        if (it < I_IN) {
            const int nb = it % (BIN / 32), kb = it / (BIN / 32), ns = 32 * nb;
            const int seg = ns >> 10, w = ns & 1023;
            if (seg < 6) { const int g = seg >> 1, t = seg & 1, hd = w >> 7, p = (w & 127) + 4 * (F.lane & 7);
                transpose_item<true>(w_in, BIN, D, ngain, WqT, 0, ns, 64 * kb, scr, F.lane, live, t * 3072 + g * 1024 + hd * 128 + 4 * pi4(p >> 2)); }
            else if (seg < 9) transpose_item<true>(w_in, BIN, D, ngain, WvT, ns, (seg - 6) * 1024 + w, 64 * kb, scr, F.lane, live);
            else transpose_item<true>(w_in, BIN, D, ngain, WqT, ns, 6144 + w, 64 * kb, scr, F.lane, live);
        } else {
            const int r = it - I_IN, nb = r % (D / 32), kb = r / (D / 32);
            transpose_item(w_out, D, D, nullptr, WoT, 32 * nb, 32 * nb, 64 * kb, scr, F.lane, live);
        }
    }
    { float* gp = (float*)(F.ws + WS_GP); for (int i = F.vcu * 512 + F.tid; i < 768; i += F.G * 512) { const int sl = i >> 7, p = i & 127; const float* src = (sl < 3 ? qgain_ : kgain_) + (sl % 3) * 128; const float v_ = src[4 * pi4(p >> 2) + (p & 3)]; if (live) gp[i] = v_; } }
    float* rope = (float*)(F.ws + WS_ROPE);
    for (int i = F.vcu * 512 + F.tid; i < SEQ * 16; i += F.G * 512) {
        const int pos = i >> 4, fi = i & 15;
        const float inv_freq = powf(500000.0f, -(float)fi / 16.0f);
        const float ang = (float)pos * inv_freq;
        const float cs_ = (float)cos((double)ang), sn_ = (float)sin((double)ang); if (live) { rope[2 * i] = cs_; rope[2 * i + 1] = sn_; }
    }
}

struct SchedB1 {
    pg8::TileOrder T; unsigned XBb;
    __device__ __forceinline__ bool next(int i, pg8::Unit& u) const {
        const bool dry_ = false; if (!T.tile(i, u.pm, u.pn)) return false; u.bswz = 0;
        u.rsa = XB8P; u.rsb = D;
        if (u.pn < 28) { u.a = XBb + (unsigned)u.pm * 256u * XB8P; u.b = (unsigned)WB_QKZ + (unsigned)u.pn * 256u * D; u.kind = (u.pn < 24) ? 0 : 1; }
        else { const int idx = u.pn - 28, g = idx >> 2, ct = idx & 3, sh = 2 * g, n0 = u.pm * 256, L = SEQ >> sh, r = n0 >> (13 - sh), l0 = n0 & (L - 1);
               u.a = (unsigned)WB_V + (unsigned)(g * 1024 + 256 * ct) * D; u.b = XBb + (unsigned)((l0 << sh) + r) * XB8P; u.rsa = D; u.rsb = XB8P << sh; u.kind = 2; u.bswz = 1; }
        if (dry_) u.kind = 99;
        return true;
    }
};
__device__ __forceinline__ float rx8_of(const LAS float* xl, int i) { return rx_of(xl, i) * F8_WINV; }
struct EpiB1 {
    static constexpr bool PERM = true;
    bf16* S0; bf16* ZSb; const float* XSSb; const float* gperm; const float* rope; bool live;
    __device__ __forceinline__ void prefetch(const pg8::Unit& u, LAS unsigned char* lds, int par, int w) const {
        const int kind_ = u.kind & 15;
        if (kind_ < 2) xss_prefetch256(XSSb + (size_t)u.pm * 256 * 4, lds, par, w);
        else if (kind_ == 2) {
            const int idx = u.pn - 28, g = idx >> 2, sh = 2 * g, n0 = u.pm * 256, L = SEQ >> sh, r = n0 >> (13 - sh), l0 = n0 & (L - 1), tok0 = (l0 << sh) + r;
            int cc = 64 * w + lane_id(); cc ^= (((cc >> 2) ^ (cc >> 3)) & 1) * 12;
            __builtin_amdgcn_global_load_lds((const unsigned*)(XSSb + (size_t)(tok0 + (cc << sh)) * 4), (LAS unsigned*)(lds + RXL_OFF + par * 4096 + w * 1024), 16, 0, 0);
        }
    }
    __device__ __forceinline__ void operator()(const f32x4 (&acc)[2][2][4][2], const pg8::Unit& u, int wr, int wc, int fr, int fq, LAS unsigned char* lds, int par) const {
        const LAS float* XL = (const LAS float*)(lds + RXL_OFF + par * 4096);
        const int kind_ = u.kind;
        asm volatile("" : "+v"(fr), "+v"(fq));
        if (kind_ == 0) {
            const int seg = u.pn >> 2, g = seg >> 1, isk = seg & 1, ct = u.pn & 3;
            unsigned char* dst = (unsigned char*)S0 + (BB_Q8 - WS_BIG) + (size_t)(isk * 3 + g) * SLAB8;
            const float* gain = gperm + (isk * 3 + g) * 128 + wc * 32 + 8 * fq;
            LAS float* T = (LAS float*)(lds + XCH_OFF);
            float rxs[8];
            const f32x4 g0 = *(const f32x4*)(gain), g1 = *(const f32x4*)(gain + 4);
            f32x4 cs[2][2];
            { const f32x4* rp = (const f32x4*)(rope + ((size_t)(u.pm * 256 + wr * 64 + fr) * 16 + 4 * wc) * 2); cs[0][0] = rp[0]; cs[0][1] = rp[1]; }
#pragma unroll
            for (int ai = 0; ai < 2; ++ai)
#pragma unroll
                for (int m = 0; m < 4; ++m) {
                    const int rl = ai * 128 + wr * 64 + m * 16 + fr; const float rx = rx8_of(XL, rl); rxs[ai * 4 + m] = rx;
#pragma unroll
                    for (int bj = 0; bj < 2; ++bj) {
                        const f32x4 v0 = acc[ai][bj][m][0], v1 = acc[ai][bj][m][1];
                        float s = (v0[0] * v0[0] + v0[1] * v0[1]) + (v0[2] * v0[2] + v0[3] * v0[3]) + (v1[0] * v1[0] + v1[1] * v1[1]) + (v1[2] * v1[2] + v1[3] * v1[3]);
                        s = sum_x32(sum_x16(s)) * (rx * rx);
                        if (fq == 0) T[(rl * 2 + bj) * 4 + wc] = s;
                    }
                }
            LDS_WAIT(); __builtin_amdgcn_s_barrier(); asm volatile("" : "+v"(fr), "+v"(fq) :: "memory");
            const float* rp0 = rope + ((size_t)(u.pm * 256 + wr * 64 + fr) * 16 + 4 * wc) * 2;
#define QK_ROPE_LOAD(k_) do { const f32x4* rp = (const f32x4*)(rp0 + (size_t)((((k_) >> 2) * 128 + ((k_) & 3) * 16) * 32)); cs[(k_) & 1][0] = rp[0]; cs[(k_) & 1][1] = rp[1]; } while (0)
#pragma unroll
            for (int k = 0; k < 8; ++k) {
                const int ai = k >> 2, m = k & 3;
                const int rl = ai * 128 + wr * 64 + m * 16 + fr, pos = u.pm * 256 + rl; const float rx = rxs[k];
                if (k < 7) QK_ROPE_LOAD(k + 1);
                const f32x4 c0 = cs[k & 1][0], c1 = cs[k & 1][1];
                const bool lo = fq < 2, isr = (fq & 1) == 0;
#pragma unroll
                for (int bj = 0; bj < 2; ++bj) {
                    const f32x4 t4 = *(const LAS f32x4*)(T + (rl * 2 + bj) * 4);
                    const float rh = rx * __builtin_amdgcn_rsqf(((t4[0] + t4[1]) + (t4[2] + t4[3])) * (1.f / 128.f) + EPS);
                    f32x4 v0 = acc[ai][bj][m][0] * rh * g0, v1 = acc[ai][bj][m][1] * rh * g1;
                    f32x4 o0;
#pragma unroll
                    for (int e = 0; e < 4; ++e) o0[e] = get_x32(v0[e], lo);
                    const float sg = lo ? -1.f : 1.f;
                    const float r0 = v0[0] * c0[0] + sg * o0[0] * c0[1], r1 = v0[1] * c0[2] + sg * o0[1] * c0[3], r2 = v0[2] * c1[0] + sg * o0[2] * c1[1], r3 = v0[3] * c1[2] + sg * o0[3] * c1[3];
                    if (isr) { v0[0] = r0; v0[1] = r1; v0[2] = r2; v0[3] = r3; }
                    u32x2 w; w.x = pk8(v0[0], v0[1], v0[2], v0[3]); w.y = pk8(v1[0], v1[1], v1[2], v1[3]);
                    if (live) *(u32x2*)(dst + (size_t)pos * 1024 + (2 * ct + bj) * 128 + wc * 32 + 8 * fq) = w;
                }
            }
#undef QK_ROPE_LOAD
        } else if (kind_ == 1) {
            bf16* dst = ZSb;
            const int col0 = (u.pn - 24) * 256 + wc * 32 + 8 * fq;
#pragma unroll
            for (int ai = 0; ai < 2; ++ai)
#pragma unroll
                for (int m = 0; m < 4; ++m) {
                    const int pos = u.pm * 256 + ai * 128 + wr * 64 + m * 16 + fr; const float rx = rx8_of(XL, ai * 128 + wr * 64 + m * 16 + fr);
#pragma unroll
                    for (int bj = 0; bj < 2; ++bj) {
                        f32x4 v0 = acc[ai][bj][m][0] * rx, v1 = acc[ai][bj][m][1] * rx;
#pragma unroll
                        for (int e = 0; e < 4; ++e) { v0[e] = silu_f(v0[e]); v1[e] = silu_f(v1[e]); }
                        u32x4 w; w.x = cvtpk(v0[0], v0[1]); w.y = cvtpk(v0[2], v0[3]); w.z = cvtpk(v1[0], v1[1]); w.w = cvtpk(v1[2], v1[3]);
                        if (live) *(u32x4*)(dst + (size_t)pos * 1024 + col0 + bj * 128) = w;
                    }
                }
        } else if (kind_ == 2) {
            const int idx = u.pn - 28, g = idx >> 2, ct = idx & 3, sh = 2 * g, n0 = u.pm * 256, L = SEQ >> sh, r = n0 >> (13 - sh), l0 = n0 & (L - 1);
            bf16* dst = S0 + (size_t)(6 + g) * SLAB_EL; (void)r; (void)l0;
            const int cbase = wc * 32 + 8 * fq;
#pragma unroll
            for (int bj = 0; bj < 2; ++bj) {
                const int c_ = bj * 128 + cbase; const f32x4 rx0 = (f32x4){rx8_of(XL, c_), rx8_of(XL, c_ + 1), rx8_of(XL, c_ + 2), rx8_of(XL, c_ + 3)}, rx1 = (f32x4){rx8_of(XL, c_ + 4), rx8_of(XL, c_ + 5), rx8_of(XL, c_ + 6), rx8_of(XL, c_ + 7)};
#pragma unroll
                for (int ai = 0; ai < 2; ++ai)
#pragma unroll
                    for (int m = 0; m < 4; ++m) {
                        const int ch = 256 * ct + ai * 128 + wr * 64 + m * 16 + fr;
                        const f32x4 v0 = acc[ai][bj][m][0] * rx0, v1 = acc[ai][bj][m][1] * rx1;
                        u32x4 w; w.x = cvtpk(v0[0], v0[1]); w.y = cvtpk(v0[2], v0[3]); w.z = cvtpk(v1[0], v1[1]); w.w = cvtpk(v1[2], v1[3]);
                        if (live) *(u32x4*)(dst + (size_t)ch * SEQ + n0 + bj * 128 + cbase) = w;
                    }
            }
        }
    }
};

__device__ __forceinline__ int crow16(int reg, int hh) { return (reg & 3) + 8 * (reg >> 2) + 4 * hh; }

constexpr int ATT_KL = 0, ATT_KS = 136, ATT_VL = 256 * 136, ATT_VS = 528, ATT_OL = ATT_VL + 128 * 528, ATT_OS = 272;
static_assert(ATT_OL + 128 * ATT_OS <= MISC_OFF, "attention LDS map");
__device__ __forceinline__ void att_decode(int wu, int& g, int& h, int& sh, int& L, int& r, int& l0) {
    const int blk = wu & 63, hg = wu >> 6; h = hg & 7; g = hg >> 3; sh = 2 * g; L = SEQ >> sh; const int n0 = blk * 128; r = n0 >> (13 - sh); l0 = n0 & (L - 1);
}
__device__ __forceinline__ void b_attn_phase(const Frame& F, bool live = true) {
    bf16* S0 = (bf16*)(F.ws + WS_BIG); float* LSE = (float*)(F.ws + WS_LSE);
    const unsigned char* Q8 = F.ws + BB_Q8; const unsigned char* K8 = F.ws + BB_K8;
    LAS unsigned char* kl = F.lds + ATT_KL; LAS unsigned char* vl = F.lds + ATT_VL; LAS unsigned char* ol = F.lds + ATT_OL;
    const int r32 = F.lane & 31, hh = F.lane >> 5, qb = F.wave >> 1, half = F.wave & 1;
    constexpr int NU = 3 * 8 * 64;
    const int per = (NU + F.G - 1) / F.G, u0 = F.vcu * per, u1 = (u0 + per < NU) ? u0 + per : NU;
    u32x4 kch[4], vch[8];
#define ATT_LOAD(wu_, cont_) do { int g_, h_, sh_, L_, r_, l0_; att_decode(wu_, g_, h_, sh_, L_, r_, l0_); const int t_ = F.wave * 64 + lane_id(); \
        const unsigned char* Ks_ = K8 + (size_t)g_ * SLAB8 + h_ * 128 + (t_ & 7) * 16; \
        const bf16* Vs_ = S0 + (size_t)(6 + g_) * SLAB_EL + (size_t)(h_ * 128 + (t_ >> 4)) * SEQ + r_ * L_ + (t_ & 15) * 8; const int pa_ = l0_ < 128 ? 0 : l0_ - 128; \
        _Pragma("unroll") for (int k = 0; k < 2; ++k) { if (!(cont_)) { const int lk_ = l0_ - 128 + (t_ >> 3) + 64 * k, lkc_ = lk_ < 0 ? 0 : lk_; kch[k] = *(const u32x4*)(Ks_ + (size_t)((lkc_ << sh_) + r_) * 1024); } \
            kch[2 + k] = *(const u32x4*)(Ks_ + (size_t)(((l0_ + (t_ >> 3) + 64 * k) << sh_) + r_) * 1024); } \
        _Pragma("unroll") for (int k = 0; k < 4; ++k) { if (!(cont_)) vch[k] = *(const u32x4*)(Vs_ + (size_t)(32 * k) * SEQ + pa_); \
            vch[4 + k] = *(const u32x4*)(Vs_ + (size_t)(32 * k) * SEQ + l0_); } } while (0)
    int par = 0; bool cont = false;
    u32x4 qq[4];
#define ATT_LOAD_Q(wu_) do { int g_, h_, sh_, L_, r_, l0_; att_decode(wu_, g_, h_, sh_, L_, r_, l0_); \
        const unsigned char* q_ = Q8 + (size_t)g_ * SLAB8 + (size_t)(((l0_ + 32 * qb + r32) << sh_) + r_) * 1024 + h_ * 128 + 32 * hh; \
        qq[0] = *(const u32x4*)(q_); qq[1] = *(const u32x4*)(q_ + 16); qq[2] = *(const u32x4*)(q_ + 64); qq[3] = *(const u32x4*)(q_ + 80); } while (0)
    if (u0 < u1) { ATT_LOAD(u0, false); ATT_LOAD_Q(u0); }
    for (int wu = u0; wu < u1; ++wu) {
        int g, h, sh, L, r, l0; att_decode(wu, g, h, sh, L, r, l0);
        bf16* Os = S0 + (size_t)g * SLAB_EL;
        const int tl = F.wave * 64 + lane_id();
        { LAS unsigned char* ks = kl + (tl >> 3) * ATT_KS + (tl & 7) * 16; LAS unsigned char* vs = vl + (tl >> 4) * ATT_VS + (tl & 15) * 16;
#pragma unroll
          for (int k = 0; k < 2; ++k) {
            if (!cont) { LAS unsigned char* d_ = ks + (par * 128 + 64 * k) * ATT_KS; *(LAS u32x2*)(d_) = (u32x2){kch[k].x, kch[k].y}; *(LAS u32x2*)(d_ + 8) = (u32x2){kch[k].z, kch[k].w}; }
            { LAS unsigned char* d_ = ks + ((par ^ 1) * 128 + 64 * k) * ATT_KS; *(LAS u32x2*)(d_) = (u32x2){kch[2 + k].x, kch[2 + k].y}; *(LAS u32x2*)(d_ + 8) = (u32x2){kch[2 + k].z, kch[2 + k].w}; } }
#pragma unroll
          for (int k = 0; k < 4; ++k) {
            if (!cont) *(LAS u32x4*)(vs + 32 * k * ATT_VS + par * 256) = vch[k];
            *(LAS u32x4*)(vs + 32 * k * ATT_VS + (par ^ 1) * 256) = vch[4 + k]; } }
        __syncthreads();
        bool ncont = false;
        if (wu + 1 < u1) { int g_, h_, sh_, L_, r_, l0n; att_decode(wu + 1, g_, h_, sh_, L_, r_, l0n); ncont = (l0n != 0); if (ncont) ATT_LOAD(wu + 1, true); else ATT_LOAD(wu + 1, false); }
        const int lq = l0 + 32 * qb + r32, tq = (lq << sh) + r;
        f32x16 sc[5];
#pragma unroll
        for (int t = 0; t < 5; ++t) {
            const int w0 = 32 * (qb + t);
            const LAS unsigned char* kp = kl + ((par ^ (w0 >> 7)) * 128 + (w0 & 127) + r32) * ATT_KS + 32 * hh;
            f32x16 a;
#pragma unroll
            for (int i = 0; i < 16; ++i) a[i] = 0.f;
#pragma unroll
            for (int j = 0; j < 2; ++j) { const u32x2 k0 = *(const LAS u32x2*)(kp + 64 * j), k1 = *(const LAS u32x2*)(kp + 64 * j + 8), k2_ = *(const LAS u32x2*)(kp + 64 * j + 16), k3 = *(const LAS u32x2*)(kp + 64 * j + 24);
                const i32x8 kf = {(int)k0.x, (int)k0.y, (int)k1.x, (int)k1.y, (int)k2_.x, (int)k2_.y, (int)k3.x, (int)k3.y};
                const i32x8 qf = {(int)qq[2 * j].x, (int)qq[2 * j].y, (int)qq[2 * j].z, (int)qq[2 * j].w, (int)qq[2 * j + 1].x, (int)qq[2 * j + 1].y, (int)qq[2 * j + 1].z, (int)qq[2 * j + 1].w};
                a = __builtin_amdgcn_mfma_scale_f32_32x32x64_f8f6f4(kf, qf, a, 0, 0, 0, 0, 0, 0); }
            sc[t] = a;
        }
        const int lb = l0 + 32 * qb;
        float mx = -INFINITY;
#pragma unroll
        for (int t = 0; t < 5; ++t) {
            const bool tile_ok = (lb - 128 + 32 * t) >= 0;
#pragma unroll
            for (int i = 0; i < 16; ++i) {
                bool ok = tile_ok;
                if (t == 0) ok = ok && (crow16(i, hh) >= r32);
                if (t == 4) ok = ok && (crow16(i, hh) <= r32);
                const float v = (t == 0 || t == 4 || !tile_ok) ? (ok ? sc[t][i] : -INFINITY) : sc[t][i]; sc[t][i] = v; mx = fmaxf(mx, v);
            }
        }
        mx = max_x32(mx);
        const float k2 = 0.08838834764831845f * 1.4426950408889634f;
        float lsum = 0.f; const float nmk = -mx * k2;
#pragma unroll
        for (int t = 0; t < 5; ++t)
#pragma unroll
            for (int i = 0; i < 16; ++i) { const float p = __builtin_amdgcn_exp2f(__builtin_fmaf(sc[t][i], k2, nmk)); sc[t][i] = p; lsum += p; }
        lsum = sum_x32(lsum);
        __builtin_amdgcn_sched_barrier(0);
        if (wu + 1 < u1) ATT_LOAD_Q(wu + 1);
        f32x16 o[2];
#pragma unroll
        for (int d2 = 0; d2 < 2; ++d2)
#pragma unroll
            for (int i = 0; i < 16; ++i) o[d2][i] = 0.f;
        const LAS unsigned char* vp = vl + (64 * half + r32) * ATT_VS + 16 * hh;
#pragma unroll
        for (int t = 0; t < 5; ++t) {
            const int w0 = 32 * (qb + t);
            const LAS unsigned char* vpt = vp + (par ^ (w0 >> 7)) * 256 + (w0 & 127) * 2;
#pragma unroll
            for (int s2 = 0; s2 < 2; ++s2) {
                u32x4 pw; pw.x = cvtpk(sc[t][8 * s2 + 0], sc[t][8 * s2 + 1]); pw.y = cvtpk(sc[t][8 * s2 + 2], sc[t][8 * s2 + 3]);
                pw.z = cvtpk(sc[t][8 * s2 + 4], sc[t][8 * s2 + 5]); pw.w = cvtpk(sc[t][8 * s2 + 6], sc[t][8 * s2 + 7]);
                const bf16x8 pf = __builtin_bit_cast(bf16x8, pw);
#pragma unroll
                for (int d2 = 0; d2 < 2; ++d2)
                    o[d2] = __builtin_amdgcn_mfma_f32_32x32x16_bf16(*(const LAS bf16x8*)(vpt + d2 * 32 * ATT_VS + 32 * s2), pf, o[d2], 0, 0, 0);
            }
        }
        const float inv = __builtin_amdgcn_rcpf(lsum);
        if (half == 0 && hh == 0 && live) LSE[((size_t)g * SEQ + tq) * 8 + h] = mx * 0.08838834764831845f + __logf(lsum);
#pragma unroll
        for (int d2 = 0; d2 < 2; ++d2)
#pragma unroll
            for (int q4 = 0; q4 < 4; ++q4) {
                u32x2 w; w.x = cvtpk(o[d2][4 * q4 + 0] * inv, o[d2][4 * q4 + 1] * inv); w.y = cvtpk(o[d2][4 * q4 + 2] * inv, o[d2][4 * q4 + 3] * inv);
                *(LAS u32x2*)(ol + (32 * qb + r32) * ATT_OS + (64 * half + 32 * d2 + 8 * q4 + 4 * hh) * 2) = w;
            }
        __syncthreads();
#pragma unroll
        for (int k = 0; k < 4; ++k) {
            const int row = (tl >> 4) + 32 * k;
            const u32x4 w = *(const LAS u32x4*)(ol + row * ATT_OS + (tl & 15) * 16);
            if (live) *(u32x4*)(Os + (size_t)(((l0 + row) << sh) + r) * 1024 + h * 128 + (tl & 15) * 8) = w;
        }
        cont = ncont; if (ncont) par ^= 1;
    }
    __syncthreads();
#undef ATT_LOAD
#undef ATT_LOAD_Q
}
__device__ __forceinline__ void b_combine_phase(const Frame& F, int b, int wi, int nw, bool live = true) {
    const bf16* S0 = (const bf16*)(F.ws + WS_BIG); const float* LSE = (const float*)(F.ws + WS_LSE); bf16* Y = (bf16*)(F.ws + BB_Y) + (size_t)b * SEQ * 1024;
    struct Item { u32x4 o0, o1, o2, zz; float e0, e1, e2; size_t off; };
    const int stride = nw * 512;
    int i = wi * 512 + F.tid;
#define CMB_LOAD(it_, i_) do { const int tok = (i_) >> 7, c = ((i_) & 127) * 8, h = c >> 7; \
        it_.e0 = LSE[((size_t)0 * SEQ + tok) * 8 + h]; it_.e1 = LSE[((size_t)1 * SEQ + tok) * 8 + h]; it_.e2 = LSE[((size_t)2 * SEQ + tok) * 8 + h]; it_.off = (size_t)tok * 1024 + c; \
        it_.o0 = *(const u32x4*)(S0 + it_.off); it_.o1 = *(const u32x4*)(S0 + SLAB_EL + it_.off); it_.o2 = *(const u32x4*)(S0 + 2 * SLAB_EL + it_.off); it_.zz = *(const u32x4*)(Y + it_.off); } while (0)
    Item cur, nxt;
    if (i < SEQ * 128) CMB_LOAD(cur, i);
    for (; i < SEQ * 128; i += stride) {
        const bool more = i + stride < SEQ * 128;
        if (more) CMB_LOAD(nxt, i + stride);
        const float mx = fmaxf(cur.e0, fmaxf(cur.e1, cur.e2));
        float w0 = __expf(cur.e0 - mx), w1 = __expf(cur.e1 - mx), w2 = __expf(cur.e2 - mx);
        const float inv = __builtin_amdgcn_rcpf(w0 + w1 + w2); w0 *= inv; w1 *= inv; w2 *= inv;
        u32x4 y;
#define CMB(w) cvtpk((w0 * bf_lo(cur.o0.w) + w1 * bf_lo(cur.o1.w) + w2 * bf_lo(cur.o2.w)) * bf_lo(cur.zz.w), (w0 * bf_hi(cur.o0.w) + w1 * bf_hi(cur.o1.w) + w2 * bf_hi(cur.o2.w)) * bf_hi(cur.zz.w))
        y.x = CMB(x); y.y = CMB(y); y.z = CMB(z); y.w = CMB(w);
#undef CMB
        if (live) *(u32x4*)(Y + cur.off) = y;
        if (more) cur = nxt;
    }
#undef CMB_LOAD
}

__global__ void __launch_bounds__(NWAVES * 64, 2) mk_fwd(Args args) {
    extern __shared__ __attribute__((aligned(16))) unsigned char lds_raw[];
    Frame F;
    F.lds = (LAS unsigned char*)lds_raw;
    F.tid = threadIdx.x; F.lane = F.tid & 63; F.wave = __builtin_amdgcn_readfirstlane(F.tid >> 6);
    F.G = gridDim.x; { const int bx = blockIdx.x; F.vcu = (F.G % 8 == 0) ? (bx % 8) * (F.G / 8) + bx / 8 : bx; }
    F.ws = args.ws;
    volatile LAS unsigned* MISC = (volatile LAS unsigned*)(F.lds + MISC_OFF);
    for (int u = F.tid; u < (LDS_BYTES - LDSCTL_OFF) / 4; u += NWAVES * 64) ((LAS unsigned*)(F.lds + LDSCTL_OFF))[u] = 0u;
    __syncthreads();
    XcdBarrier bar = xcd_barrier_post((unsigned*)(F.ws + WS_CTL) + CW_BAR, MISC + 8);
#define GRID_BAR() xcd_barrier(bar, F.wave)
#define LOCAL_BAR() do { if (xcd_even) xcd_local_barrier(bar, F.wave); else xcd_barrier(bar, F.wave); } while (0)
#define FRESH_IDS() int mo_ = MISC_OFF + 40; asm volatile("" : "+s"(mo_)); const volatile LAS unsigned* mp_ = (const volatile LAS unsigned*)(F.lds + mo_); const unsigned xi_ = mp_[1]; const bool xcd_even = __builtin_amdgcn_readfirstlane((int)(xi_ >> 8)) != 0; int bx_ = xcd_even ? __builtin_amdgcn_readfirstlane((int)(mp_[0] * 8u + (xi_ & 255u))) : (int)blockIdx.x; asm volatile("" : "+s"(bx_)); (void)xcd_even;     F.vcu = (F.G % 8 == 0) ? (bx_ % 8) * (F.G / 8) + bx_ / 8 : bx_; F.lane = lane_id(); F.tid = F.wave * 64 + F.lane
    { FRESH_IDS(); (void)bx_;
      { bf16* XR = (bf16*)(F.ws + WS_XB); float* XSS = (float*)(F.ws + WS_XSS); const int gw = F.vcu * NWAVES + F.wave, NGW = F.G * NWAVES;
        for (int m = 2 * gw; m < M; m += 2 * NGW) x_rows_prep2(args.in[0] + (size_t)m * D, XR + (size_t)m * XBP, XSS + (size_t)m * 4, F.lane); }
      a_convert_weights(F, args.in[2], args.in[1], args.in[6], args.in[4]);
      GRID_BAR();
      }
#pragma unroll
    for (int layer = 0; layer < 4; ++layer) {
        const int kind = layer % 3;
        FRESH_IDS();
        const int is_last = (layer == 3);
        if (kind == 0) {
            { SchedA1 S; S.init(F.G, bx_); S.XB = (unsigned)WS_XB; S.W = (unsigned)WA_IN;
              EpiA1 E{(bf16*)(F.ws + BA_G), (bf16*)(F.ws + BA_VT), (const float*)(F.ws + WS_XSS), (float*)(F.ws + WS_VSS), true, (const bf16*)(F.ws + WS_WM), args.in[5] + (size_t)(layer / 3) * 8 * 128, args.in[3] + (size_t)(layer / 3) * AW, &bar, xcd_even};
              pg8::gemm_phase<EpiA1, SchedA1, true>(F.lds, F.ws, D, S, E, F.wave);
              if (!S.has_uz()) LOCAL_BAR(); }
            LOCAL_BAR();
            if (layer == 0) { b_convert_weights(F, args.in[7], args.in[1] + (size_t)1 * D, args.in[10], args.in[8], args.in[9]); __syncthreads(); }
            { SchedOut S; S.T.init(M / 256, D / 256, F.G, bx_); S.Y = (unsigned)BA_G; S.W = (unsigned)WA_OUT; S.kbytes = AW * 2;
              EpiOut E{(layer == 0) ? args.in[0] : (const float*)nullptr, (bf16*)(F.ws + WS_XB), (float*)(F.ws + WS_XSS), is_last ? args.out : (float*)nullptr, true, (layer == 0) ? F.ws + WS_XB8 : (unsigned char*)nullptr};
              pg8::gemm_phase<EpiOut, SchedOut, true>(F.lds, F.ws, AW, S, E, F.wave); }
            if (!is_last) GRID_BAR();
        }
        if (kind == 1) {
#pragma unroll 1
            for (int b = 0; b < BATCH; ++b) {
                { SchedB1 S; S.T.init(SEQ / 256, 40, F.G, bx_); S.XBb = (unsigned)WS_XB8 + (unsigned)b * (unsigned)SEQ * XB8P;
                  EpiB1 E{(bf16*)(F.ws + WS_BIG), (bf16*)(F.ws + BB_Y) + (size_t)b * SEQ * 1024, (const float*)(F.ws + WS_XSS) + (size_t)b * SEQ * 4, (const float*)(F.ws + WS_GP), (const float*)(F.ws + WS_ROPE), true};
                  pg8::gemm_phase<EpiB1, SchedB1, true, true>(F.lds, F.ws, D / 2, S, E, F.wave); }
                GRID_BAR();
                { F.lane = lane_id(); F.tid = F.wave * 64 + F.lane; }
                b_attn_phase(F);
                if (b == 1) c_convert_fold_inputs(F, args.in[11], args.in[1] + (size_t)2 * D, args.in[12]);
                GRID_BAR();
                if (b == 0) b_combine_phase(F, b, F.vcu, F.G);
                else if (bx_ < 32) { SchedFold S{F.G, bx_}; EpiPlainBf16 E{(bf16*)(F.ws + WC_IN), D, true, true};
                    pg8::gemm_phase<EpiPlainBf16, SchedFold, true>(F.lds, F.ws, 512, S, E, F.wave); }
                else { b_combine_phase(F, b, bx_ - 32, F.G - 32); c_convert_rest(F, args.in[11], args.in[1] + (size_t)2 * D, args.in[14], bx_ - 32, F.G - 32); }
                if (b == 1) GRID_BAR();
            }
            { SchedOut S; S.T.init(M / 256, D / 256, F.G, bx_); S.Y = (unsigned)BB_Y; S.W = (unsigned)WB_OUT; S.kbytes = D * 2;
              EpiOut E{(const float*)nullptr, (bf16*)(F.ws + WS_XB), (float*)(F.ws + WS_XSS), (float*)nullptr, true, (unsigned char*)nullptr};
              pg8::gemm_phase<EpiOut, SchedOut, true>(F.lds, F.ws, D, S, E, F.wave); }
            LOCAL_BAR();
        }
        if (kind == 2) {
            { SchedC1 S; S.T.init(M / 256, CIN / 256, F.G, bx_);
              EpiC1 E{(bf16*)(F.ws + BC_X), (bf16*)(F.ws + BC_Z), (const float*)(F.ws + WS_XSS), args.in[13], true};
              pg8::gemm_phase<EpiC1, SchedC1, true>(F.lds, F.ws, D, S, E, F.wave); }
            GRID_BAR();
            c_pool_phase(F, args.in[13]);
            a_convert_weights(F, args.in[2] + (size_t)1 * D * AIN, args.in[1] + (size_t)3 * D, args.in[6] + (size_t)1 * AW * D, args.in[4] + (size_t)1 * 8 * 128 * 128);
            GRID_BAR();
            { SchedOut S; S.T.init(M / 256, D / 256, F.G, bx_); S.Y = (unsigned)BC_Z; S.W = (unsigned)WC_OUT; S.kbytes = CW * 2;
              EpiOut E{(const float*)nullptr, (bf16*)(F.ws + WS_XB), (float*)(F.ws + WS_XSS), (float*)nullptr, true, (unsigned char*)nullptr};
              pg8::gemm_phase<EpiOut, SchedOut, true>(F.lds, F.ws, CW, S, E, F.wave); }
            LOCAL_BAR();
        }
    }
}

static int g_grid = 0, g_coop = 1;
static void mk_launch(void* const* d_in, void* d_out, void* d_ws, hipStream_t stream) {
    if (g_grid == 0) {
        int dev = 0, cus = 0, per_cu = 0;
        (void)hipGetDevice(&dev);
        (void)hipDeviceGetAttribute(&cus, hipDeviceAttributeMultiprocessorCount, dev);
        (void)hipFuncSetAttribute((const void*)mk_fwd, hipFuncAttributeMaxDynamicSharedMemorySize, LDS_BYTES);
        if (hipOccupancyMaxActiveBlocksPerMultiprocessor(&per_cu, (const void*)mk_fwd, NWAVES * 64, LDS_BYTES) != hipSuccess) per_cu = 0;
        (void)hipGetLastError();
        if (per_cu < 1) fprintf(stderr, "kernel_launch: occupancy query reports %d blocks per CU for %d B of LDS\n", per_cu, LDS_BYTES);
        g_grid = (cus > 0 ? cus : 256);
    }
    (void)hipMemsetAsync((char*)d_ws + WS_CTL, 0, CTL_ZERO_BYTES, stream);
    Args a{};
    for (int i = 0; i < 15; ++i) a.in[i] = (const float*)d_in[i];
    a.out = (float*)d_out; a.ws = (unsigned char*)d_ws;
    void* params[] = {&a};
    hipError_t e = hipErrorUnknown;
    if (g_coop) {
        e = hipLaunchCooperativeKernel((const void*)mk_fwd, dim3(g_grid), dim3(NWAVES * 64), params, LDS_BYTES, stream);
        if (e != hipSuccess) { fprintf(stderr, "cooperative launch failed: %s; falling back to a plain launch\n", hipGetErrorString(e)); (void)hipGetLastError(); g_coop = 0; }
    }
    if (!g_coop) hipLaunchKernelGGL(mk_fwd, dim3(g_grid), dim3(NWAVES * 64), LDS_BYTES, stream, a);
}

extern "C" void kernel_launch(void* const* d_in, const int* in_sizes, int n_in, void* d_out, int out_size, void* d_ws, size_t ws_size, hipStream_t stream) {
    if (n_in != 15 || out_size != M * D || ws_size < WS_END) { fprintf(stderr, "kernel_launch: unexpected sizes (n_in %d out %d ws %zu)\n", n_in, out_size, ws_size); return; }
    mk_launch(d_in, d_out, d_ws, stream);
}
```
